# Optimizing an MI355X kernel written in HIP

```python
import jax
import jax.numpy as jnp
from jax import lax
import numpy as np

D_MODEL = 2048
BATCH = 4
SEQ = 4096
DEPTH = 1

NSA_HEADS = 16
NSA_GROUPS = 4
NSA_HEADS_PER_GROUP = NSA_HEADS // NSA_GROUPS
NSA_HEAD_DIM = 64
NSA_ROPE_DIM = NSA_HEAD_DIM // 4
CMP_BLOCK = 32
CMP_STRIDE = 16
CMP_HIDDEN = 256
SEL_BLOCK = 64
SEL_TOPK = 16
WINDOW = 512
N_NSA_BRANCHES = 3
MLA_HEADS = 16
MLA_Q_RANK = 512
MLA_KV_RANK = 256
MLA_NOPE_DIM = 64
MLA_ROPE_DIM = 32
MLA_V_DIM = 64
PEER_HEADS = 8
PEER_N_KEYS = 128
PEER_N_EXPERTS = PEER_N_KEYS * PEER_N_KEYS
PEER_QUERY_DIM = 256
PEER_TOPK = 16
PEER_TOKEN_BLOCK = 128
N_BRANCHES = 2
ROPE_THETA = 500000.0
NORM_EPS = 1e-6
Q_BLOCK = 128
SEL_Q_BLOCK = 32
NEG_INF = -1e30
FORCE_BONUS = 1e4

IN_SIZES = (NSA_HEADS * NSA_HEAD_DIM,
            N_NSA_BRANCHES * 2 * NSA_GROUPS * NSA_HEAD_DIM,
            N_NSA_BRANCHES * NSA_HEADS,
            MLA_Q_RANK,
            MLA_KV_RANK,
            MLA_ROPE_DIM,
            N_BRANCHES * D_MODEL)
IN_COLS = sum(IN_SIZES)

kernel_name = 'hybrid_nsa_mla_peer_block'


def rms_norm(x, g):
    xf = x.astype(jnp.float32)
    y = xf * lax.rsqrt(jnp.mean(xf * xf, axis=-1, keepdims=True) + NORM_EPS)
    return (y * g.astype(jnp.float32)).astype(x.dtype)


def masked_softmax(s, mask):
    s = jnp.where(mask, s.astype(jnp.float32), NEG_INF)
    return jax.nn.softmax(s, axis=-1) * mask


def apply_rope(x, positions, rot_dim):
    half = rot_dim // 2
    inv_freq = ROPE_THETA ** (-jnp.arange(half, dtype=jnp.float32) * (2.0 / rot_dim))
    ang = positions.astype(jnp.float32)[:, :, None] * inv_freq
    cos = jnp.cos(ang)[:, :, None, :]
    sin = jnp.sin(ang)[:, :, None, :]
    xr = x[..., :rot_dim].astype(jnp.float32)
    x1, x2 = xr[..., :half], xr[..., half:]
    rot = jnp.concatenate([x1 * cos - x2 * sin, x2 * cos + x1 * sin], axis=-1)
    return jnp.concatenate([rot.astype(x.dtype), x[..., rot_dim:]], axis=-1)


def map_query_blocks(fn, seq_len, block):
    starts = jnp.arange(seq_len // block, dtype=jnp.int32) * block
    out = lax.map(fn, starts)

    def merge(a):
        a = jnp.moveaxis(a, 0, 1)
        return a.reshape((a.shape[0], seq_len) + a.shape[3:])
    return jax.tree_util.tree_map(merge, out)


def compress_blocks(kraw, pe, w1, b1, w2):
    B, T, G, d = kraw.shape
    n_cmp = (T - CMP_BLOCK) // CMP_STRIDE + 1
    idx = jnp.arange(n_cmp)[:, None] * CMP_STRIDE + jnp.arange(CMP_BLOCK)[None, :]
    blk = kraw[:, idx] + pe[:, None, :]
    blk = jnp.transpose(blk, (0, 1, 3, 2, 4)).reshape(B, n_cmp, G, CMP_BLOCK * d)
    return jax.nn.gelu(blk @ w1 + b1) @ w2


def nsa_attention(q_in, kv_in, gate_in, positions, cmp_pe, cmp_w1, cmp_b1, cmp_w2):
    B, T, _ = q_in.shape
    dt = q_in.dtype
    G, R, d = NSA_GROUPS, NSA_HEADS_PER_GROUP, NSA_HEAD_DIM
    scale = d ** -0.5
    q = apply_rope(q_in.reshape(B, T, NSA_HEADS, d), positions, NSA_ROPE_DIM).reshape(B, T, G, R, d)
    kv = kv_in.reshape(B, T, N_NSA_BRANCHES, 2, G, d)
    k_cmp = compress_blocks(apply_rope(kv[:, :, 0, 0], positions, NSA_ROPE_DIM),
                            cmp_pe[0], cmp_w1[0], cmp_b1[0], cmp_w2[0])
    v_cmp = compress_blocks(kv[:, :, 0, 1], cmp_pe[1], cmp_w1[1], cmp_b1[1], cmp_w2[1])
    k_sel = apply_rope(kv[:, :, 1, 0], positions, NSA_ROPE_DIM)
    v_sel = kv[:, :, 1, 1]
    k_win = apply_rope(kv[:, :, 2, 0], positions, NSA_ROPE_DIM)
    v_win = kv[:, :, 2, 1]

    n_cmp = k_cmp.shape[1]
    n_sel = T // SEL_BLOCK
    n_top = min(SEL_TOPK, n_sel)
    cmp_start = jnp.arange(n_cmp, dtype=jnp.int32) * CMP_STRIDE
    cmp_end = cmp_start + CMP_BLOCK - 1
    sel_start = jnp.arange(n_sel, dtype=jnp.int32) * SEL_BLOCK
    overlap = ((cmp_start[:, None] < sel_start[None, :] + SEL_BLOCK)
               & (cmp_end[:, None] >= sel_start[None, :])).astype(jnp.float32)
    blk_id = jnp.arange(n_sel, dtype=jnp.int32)
    k_blk = jnp.transpose(k_sel.reshape(B, n_sel, SEL_BLOCK, G, d), (0, 3, 1, 2, 4))
    v_blk = jnp.transpose(v_sel.reshape(B, n_sel, SEL_BLOCK, G, d), (0, 3, 1, 2, 4))
    b_ix = jnp.arange(B)[:, None, None, None]
    g_ix = jnp.arange(G)[None, None, :, None]
    in_blk = jnp.arange(SEL_BLOCK, dtype=jnp.int32)

    def cmp_sel_block(s):
        qb = lax.dynamic_slice_in_dim(q, s, SEL_Q_BLOCK, axis=1)
        t = s + jnp.arange(SEL_Q_BLOCK, dtype=jnp.int32)
        sc = jnp.einsum('bqgrd,bngd->bgrqn', qb, k_cmp) * scale
        p_cmp = masked_softmax(sc, cmp_end[None, :] <= t[:, None])
        o_cmp = jnp.einsum('bgrqn,bngd->bqgrd', p_cmp.astype(dt), v_cmp)
        imp = jnp.einsum('bgrqn,ns->bqgs', p_cmp, overlap)
        t_blk = t // SEL_BLOCK
        forced = ((blk_id[None, :] == 0) | (blk_id[None, :] == t_blk[:, None])
                  | (blk_id[None, :] == t_blk[:, None] - 1))
        valid = sel_start[None, :] <= t[:, None]
        imp = jnp.where(valid[None, :, None, :], imp + FORCE_BONUS * forced[None, :, None, :], NEG_INF)
        _, sel = lax.top_k(imp, n_top)
        kg = k_blk[b_ix, g_ix, sel]
        vg = v_blk[b_ix, g_ix, sel]
        tok = sel[..., None] * SEL_BLOCK + in_blk
        smask = (tok <= t[None, :, None, None, None]).reshape(B, SEL_Q_BLOCK, G, 1, n_top * SEL_BLOCK)
        ss = jnp.einsum('bqgrd,bqgkld->bqgrkl', qb, kg) * scale
        p_sel = masked_softmax(ss.reshape(B, SEL_Q_BLOCK, G, R, n_top * SEL_BLOCK), smask)
        o_sel = jnp.einsum('bqgrm,bqgmd->bqgrd', p_sel.astype(dt),
                           vg.reshape(B, SEL_Q_BLOCK, G, n_top * SEL_BLOCK, d))
        return o_cmp, o_sel

    k_pad = jnp.pad(k_win, ((0, 0), (WINDOW, 0), (0, 0), (0, 0)))
    v_pad = jnp.pad(v_win, ((0, 0), (WINDOW, 0), (0, 0), (0, 0)))

    def win_block(s):
        qb = lax.dynamic_slice_in_dim(q, s, Q_BLOCK, axis=1)
        kb = lax.dynamic_slice_in_dim(k_pad, s, WINDOW + Q_BLOCK, axis=1)
        vb = lax.dynamic_slice_in_dim(v_pad, s, WINDOW + Q_BLOCK, axis=1)
        t = s + jnp.arange(Q_BLOCK, dtype=jnp.int32)
        j = s - WINDOW + jnp.arange(WINDOW + Q_BLOCK, dtype=jnp.int32)
        band = (j[None, :] >= 0) & (j[None, :] <= t[:, None]) & (t[:, None] - j[None, :] < WINDOW)
        sc = jnp.einsum('bqgrd,bkgd->bqgrk', qb, kb) * scale
        p = masked_softmax(sc, band[None, :, None, None, :])
        return jnp.einsum('bqgrk,bkgd->bqgrd', p.astype(dt), vb)

    o_cmp, o_sel = map_query_blocks(cmp_sel_block, T, SEL_Q_BLOCK)
    o_win = map_query_blocks(win_block, T, Q_BLOCK)
    g = jax.nn.sigmoid(gate_in.astype(jnp.float32)).astype(dt).reshape(B, T, G, R, N_NSA_BRANCHES)
    o = g[..., 0:1] * o_cmp + g[..., 1:2] * o_sel + g[..., 2:3] * o_win
    return o.reshape(B, T, NSA_HEADS * d)


def mla_attention(c_q, c_kv, k_r, positions, q_norm_g, w_q_up, kv_norm_g, w_kv_up):
    B, T, _ = c_q.shape
    dt = c_q.dtype
    H = MLA_HEADS
    scale = (MLA_NOPE_DIM + MLA_ROPE_DIM) ** -0.5
    q = (rms_norm(c_q, q_norm_g) @ w_q_up).reshape(B, T, H, MLA_NOPE_DIM + MLA_ROPE_DIM)
    q_nope = q[..., :MLA_NOPE_DIM]
    q_rope = apply_rope(q[..., MLA_NOPE_DIM:], positions, MLA_ROPE_DIM)
    kv = (rms_norm(c_kv, kv_norm_g) @ w_kv_up).reshape(B, T, H, MLA_NOPE_DIM + MLA_V_DIM)
    k_nope = kv[..., :MLA_NOPE_DIM]
    v = kv[..., MLA_NOPE_DIM:]
    k_rope = apply_rope(k_r[:, :, None, :], positions, MLA_ROPE_DIM)[:, :, 0]
    key_pos = jnp.arange(T, dtype=jnp.int32)

    def mla_block(s):
        qn = lax.dynamic_slice_in_dim(q_nope, s, Q_BLOCK, axis=1)
        qr = lax.dynamic_slice_in_dim(q_rope, s, Q_BLOCK, axis=1)
        t = s + jnp.arange(Q_BLOCK, dtype=jnp.int32)
        sc = (jnp.einsum('bqhd,bkhd->bhqk', qn, k_nope)
              + jnp.einsum('bqhd,bkd->bhqk', qr, k_rope)) * scale
        p = masked_softmax(sc, (key_pos[None, :] <= t[:, None])[None, None])
        return jnp.einsum('bhqk,bkhd->bqhd', p.astype(dt), v)

    o = map_query_blocks(mla_block, T, Q_BLOCK)
    return o.reshape(B, T, H * MLA_V_DIM)


def token_mixer(h, positions, w_in, cmp_pe, cmp_w1, cmp_b1, cmp_w2, mla_q_norm_g, mla_w_q_up,
                mla_kv_norm_g, mla_w_kv_up, w_branch_nsa, w_branch_mla, w_out):
    B, T, _ = h.shape
    dt = h.dtype
    proj = h @ w_in
    parts = []
    off = 0
    for n in IN_SIZES:
        parts.append(proj[..., off:off + n])
        off += n
    q_nsa, kv_nsa, g_nsa, c_q, c_kv, k_r, g_merge = parts
    o_nsa = nsa_attention(q_nsa, kv_nsa, g_nsa, positions, cmp_pe, cmp_w1, cmp_b1, cmp_w2)
    o_mla = mla_attention(c_q, c_kv, k_r, positions, mla_q_norm_g, mla_w_q_up, mla_kv_norm_g, mla_w_kv_up)
    gates = jax.nn.sigmoid(g_merge.astype(jnp.float32)).astype(dt).reshape(B, T, N_BRANCHES, D_MODEL)
    merged = gates[:, :, 0] * (o_nsa @ w_branch_nsa) + gates[:, :, 1] * (o_mla @ w_branch_mla)
    return merged @ w_out


def peer_ffn(h, w_q, sub_keys, u, v):
    B, T, D = h.shape
    dt = h.dtype
    half = PEER_QUERY_DIM // 2
    qry = (h @ w_q).reshape(B, T, PEER_HEADS, 2, half)
    s = jnp.einsum('bthpd,hpnd->bthpn', qry, sub_keys).astype(jnp.float32)
    s1, i1 = lax.top_k(s[:, :, :, 0], PEER_TOPK)
    s2, i2 = lax.top_k(s[:, :, :, 1], PEER_TOPK)
    n_cand = PEER_TOPK * PEER_TOPK
    cand_s = (s1[..., :, None] + s2[..., None, :]).reshape(B, T, PEER_HEADS, n_cand)
    cand_i = (i1[..., :, None] * PEER_N_KEYS + i2[..., None, :]).reshape(B, T, PEER_HEADS, n_cand)
    top_s, pos = lax.top_k(cand_s, PEER_TOPK)
    expert = jnp.take_along_axis(cand_i, pos, axis=-1)
    gate = jax.nn.softmax(top_s, axis=-1).astype(dt)
    n_tok = B * T
    n_pick = PEER_HEADS * PEER_TOPK
    hf = h.reshape(n_tok, D)
    ef = expert.reshape(n_tok, n_pick)
    gf = gate.reshape(n_tok, n_pick)

    def expert_block(s0):
        hs = lax.dynamic_slice_in_dim(hf, s0, PEER_TOKEN_BLOCK, 0)
        es = lax.dynamic_slice_in_dim(ef, s0, PEER_TOKEN_BLOCK, 0)
        gs = lax.dynamic_slice_in_dim(gf, s0, PEER_TOKEN_BLOCK, 0)
        act = jax.nn.gelu(jnp.einsum('cd,ced->ce', hs, u[es]))
        return jnp.einsum('ce,ced->cd', gs * act, v[es])

    starts = jnp.arange(n_tok // PEER_TOKEN_BLOCK, dtype=jnp.int32) * PEER_TOKEN_BLOCK
    y = lax.map(expert_block, starts)
    return y.reshape(B, T, D)


def setup_inputs(seed: int = 0) -> dict:
    key = jax.random.key(seed)
    ks = jax.random.split(key, 26)
    L, D = DEPTH, D_MODEL

    def nrm(k, shape, scale):
        return jax.random.normal(k, shape, jnp.float32) * scale

    def gain(k, shape):
        return 1.0 + 0.01 * jax.random.normal(k, shape, jnp.float32)

    offset = jax.random.randint(ks[2], (BATCH, 1), 0, 1024, dtype=jnp.int32)
    nsa_w = NSA_HEADS * NSA_HEAD_DIM
    mla_w = MLA_HEADS * MLA_V_DIM
    return {
        'x': nrm(ks[0], (BATCH, SEQ, D), 1.0),
        'c': nrm(ks[1], (BATCH, D), 1.0),
        'positions': offset + jnp.arange(SEQ, dtype=jnp.int32)[None, :],
        'ada_w': nrm(ks[3], (L, D, 6 * D), 0.5 * D ** -0.5),
        'ada_b': nrm(ks[4], (L, 6 * D), 0.02),
        'attn_pre_g': gain(ks[5], (L, D)),
        'attn_post_g': gain(ks[6], (L, D)),
        'w_in': nrm(ks[7], (L, D, IN_COLS), D ** -0.5),
        'cmp_pe': nrm(ks[8], (L, 2, CMP_BLOCK, NSA_HEAD_DIM), 0.1),
        'cmp_w1': nrm(ks[9], (L, 2, CMP_BLOCK * NSA_HEAD_DIM, CMP_HIDDEN), (CMP_BLOCK * NSA_HEAD_DIM) ** -0.5),
        'cmp_b1': nrm(ks[10], (L, 2, CMP_HIDDEN), 0.02),
        'cmp_w2': nrm(ks[11], (L, 2, CMP_HIDDEN, NSA_HEAD_DIM), CMP_HIDDEN ** -0.5),
        'mla_q_norm_g': gain(ks[12], (L, MLA_Q_RANK)),
        'mla_w_q_up': nrm(ks[13], (L, MLA_Q_RANK, MLA_HEADS * (MLA_NOPE_DIM + MLA_ROPE_DIM)), MLA_Q_RANK ** -0.5),
        'mla_kv_norm_g': gain(ks[14], (L, MLA_KV_RANK)),
        'mla_w_kv_up': nrm(ks[15], (L, MLA_KV_RANK, MLA_HEADS * (MLA_NOPE_DIM + MLA_V_DIM)), MLA_KV_RANK ** -0.5),
        'w_branch_nsa': nrm(ks[16], (L, nsa_w, D), nsa_w ** -0.5),
        'w_branch_mla': nrm(ks[17], (L, mla_w, D), mla_w ** -0.5),
        'w_out': nrm(ks[18], (L, D, D), D ** -0.5),
        'ffn_pre_g': gain(ks[19], (L, D)),
        'ffn_post_g': gain(ks[20], (L, D)),
        'peer_w_q': nrm(ks[21], (L, D, PEER_HEADS * PEER_QUERY_DIM), D ** -0.5),
        'peer_sub_keys': nrm(ks[22], (L, PEER_HEADS, 2, PEER_N_KEYS, PEER_QUERY_DIM // 2), (PEER_QUERY_DIM // 2) ** -0.5),
        'peer_u': nrm(ks[23], (L, PEER_N_EXPERTS, D), D ** -0.5),
        'peer_v': nrm(ks[24], (L, PEER_N_EXPERTS, D), D ** -0.5),
    }


def reference(x, c, positions, ada_w, ada_b, attn_pre_g, attn_post_g, w_in, cmp_pe, cmp_w1, cmp_b1,
              cmp_w2, mla_q_norm_g, mla_w_q_up, mla_kv_norm_g, mla_w_kv_up, w_branch_nsa, w_branch_mla,
              w_out, ffn_pre_g, ffn_post_g, peer_w_q, peer_sub_keys, peer_u, peer_v):
    for l in range(DEPTH):
        mod = jax.nn.silu(c) @ ada_w[l] + ada_b[l]
        sh_a, sc_a, g_a, sh_f, sc_f, g_f = [m[:, None, :] for m in jnp.split(mod, 6, axis=-1)]
        h = rms_norm(x, attn_pre_g[l]) * (1 + sc_a) + sh_a
        y = token_mixer(h, positions, w_in[l], cmp_pe[l], cmp_w1[l], cmp_b1[l], cmp_w2[l],
                        mla_q_norm_g[l], mla_w_q_up[l], mla_kv_norm_g[l], mla_w_kv_up[l],
                        w_branch_nsa[l], w_branch_mla[l], w_out[l])
        x = x + g_a * rms_norm(y, attn_post_g[l])
        h = rms_norm(x, ffn_pre_g[l]) * (1 + sc_f) + sh_f
        y = peer_ffn(h, peer_w_q[l], peer_sub_keys[l], peer_u[l], peer_v[l])
        x = x + g_f * rms_norm(y, ffn_post_g[l])
    return x
```

```cpp
#ifdef HOST_EMU
#include "emu.h"
#else
#include <hip/hip_runtime.h>
#include <hip/hip_cooperative_groups.h>
#include <cstdio>
namespace cg = cooperative_groups;
#endif
#include <stdint.h>

#define DI __device__ __forceinline__

#ifdef SMALL_CFG
constexpr int D_MODEL = 512, BATCH = 1, SEQ = 2048;
#else
constexpr int D_MODEL = 2048, BATCH = 4, SEQ = 4096;
#endif
constexpr int NTOK = BATCH * SEQ;
constexpr int NH = 16, NG = 4, HD = 64;
constexpr int CMP_HIDDEN = 256;
constexpr int NCP = SEQ / 16;
constexpr int NSEL = SEQ / 64;
constexpr int WINDOW = 512;
constexpr int QR = 512, KVR = 256;
constexpr int MQK = 96;
constexpr int PH = 8, PNK = 128, PQD = 256, PTOPK = 16;
constexpr int NEXP = PNK * PNK;
constexpr int NPICK = PH * PTOPK;
constexpr float NORM_EPS = 1e-6f;
constexpr int IN_COLS = 1024 + 1536 + 48 + 512 + 256 + 32 + 2 * D_MODEL;
constexpr int PC_Q = 0, PC_KV = 1024, PC_CQ = 2560, PC_CKV = 3072, PC_GM = 3328, PC_KR = PC_GM + 2 * D_MODEL, PC_GN = PC_KR + 32;
constexpr int NPROJ = ((PC_GN + 48 + 255) / 256) * 256;
constexpr int NPROJ_VALID = ((PC_GN + 48 + 127) / 128) * 128;
constexpr int GMT = 2 * D_MODEL / 128;
constexpr int NT_LAST = 26 + GMT;
static_assert(NPROJ_VALID / 128 == NT_LAST + 1, "proj tiles");
static_assert((NTOK * NG / 16) % 256 == 0 && NTOK % 256 == 0 && SEQ % 256 == 0, "row tiling");

#ifndef PH_MASK
#define PH_MASK 0xFFFF
#endif
#define PH_ON(k) (((PH_MASK) >> (k)) & 1)
#ifndef REP
#define REP (-1)
#endif
#define REPS(k) ((REP) == (k) ? 2 : 1)
constexpr int NTHREADS = 512, NW = NTHREADS / 64;
constexpr int LDS_MAIN = 147456;
constexpr int LDS_BYTES = LDS_MAIN + 256;
constexpr int ST_LD = 129;
constexpr int AB_STR = 144;

typedef unsigned short bf16_t;
typedef short bf16x8 __attribute__((ext_vector_type(8)));
typedef short bf16x4 __attribute__((ext_vector_type(4)));
typedef float f32x16 __attribute__((ext_vector_type(16)));
typedef float f32x4 __attribute__((ext_vector_type(4)));
typedef float f32x2 __attribute__((ext_vector_type(2)));
typedef unsigned u32x4 __attribute__((ext_vector_type(4)));
typedef unsigned u32x2 __attribute__((ext_vector_type(2)));

DI float u2f(unsigned u) { float f; __builtin_memcpy(&f, &u, 4); return f; }
DI unsigned f2u(float f) { unsigned u; __builtin_memcpy(&u, &f, 4); return u; }
DI float bf2f(bf16_t v) { return u2f((unsigned)v << 16); }
DI float bflo(unsigned u) { return u2f(u << 16); }
DI float bfhi(unsigned u) { return u2f(u & 0xffff0000u); }
#ifdef HOST_EMU
DI bf16_t f2bf(float x) { unsigned u = f2u(x); u += 0x7fffu + ((u >> 16) & 1u); return (bf16_t)(u >> 16); }
DI unsigned pack2(float lo, float hi) { return (unsigned)f2bf(lo) | ((unsigned)f2bf(hi) << 16); }
DI float fexp2(float x) { return exp2f(x); }
DI float frcp(float x) { return 1.0f / x; }
DI float frsq(float x) { return 1.0f / sqrtf(x); }
DI float fsin_rev(float x) { return sinf(6.283185307179586f * x); }
DI float fcos_rev(float x) { return cosf(6.283185307179586f * x); }
DI int bcast_i(int v, int l) { return __shfl(v, l); }
DI void grid_sync() { emu_grid_sync(); }
#define LDS_PTR() (emu_cur->blk->smem)
#else
typedef __bf16 bf16v2 __attribute__((ext_vector_type(2)));
DI unsigned pack2(float lo, float hi) { f32x2 v = {lo, hi}; bf16v2 r = __builtin_convertvector(v, bf16v2); return __builtin_bit_cast(unsigned, r); }
DI bf16_t f2bf(float x) { return (bf16_t)(pack2(x, 0.f) & 0xffffu); }
DI float fexp2(float x) { return __builtin_amdgcn_exp2f(x); }
DI float frcp(float x) { return __builtin_amdgcn_rcpf(x); }
DI float frsq(float x) { return __builtin_amdgcn_rsqf(x); }
DI float fsin_rev(float x) { return __builtin_amdgcn_sinf(x); }
DI float fcos_rev(float x) { return __builtin_amdgcn_cosf(x); }
DI int bcast_i(int v, int l) { return __builtin_amdgcn_readlane(v, l); }
DI void grid_sync() { cg::this_grid().sync(); }
extern __shared__ __attribute__((aligned(16))) char dyn_lds[];
#define LDS_PTR() (dyn_lds)
#endif
DI float bcast_f(float v, int l) { return u2f((unsigned)bcast_i((int)f2u(v), l)); }
DI int shfl_i(int v, int l) { return __shfl(v, l); }
DI float shfl_f(float v, int l) { return __shfl(v, l); }
#ifdef HOST_EMU
DI int tid() { return threadIdx.x; }
#else
DI int tid() { int t = threadIdx.x; asm volatile("" : "+v"(t)); return t; }
#endif
#ifdef HOST_EMU
#define GLD16(ptr) (*(const u32x4*)(ptr))
#else
#define GLD16(ptr) (*(const __attribute__((address_space(1))) u32x4*)(const __attribute__((address_space(1))) void*)(ptr))
#endif
DI float fsigmoid(float x) { return frcp(1.0f + fexp2(-1.4426950408889634f * x)); }
DI float fgelu_tanh(float x) { const float z2 = 2.0f * 0.7978845608028654f * (x + 0.044715f * x * x * x); return x * frcp(1.0f + fexp2(-1.4426950408889634f * z2)); }

#ifdef HOST_EMU
DI unsigned emu_f2e4m3(float x) { unsigned sgn = x < 0 ? 0x80u : 0u; float a = fabsf(x); if (!(a == a)) return sgn | 0x7f; if (a > 448.f) a = 448.f;
  if (a < 0.0009765625f) return sgn;
  int e; frexpf(a, &e); int ex = e - 1; if (ex < -6) ex = -6;
  float q = ldexpf(a, 3 - ex); float r = nearbyintf(q);
  if (r >= 16.f) { r = 8.f; ex += 1; }
  unsigned bits; if (r < 8.f) bits = (unsigned)r; else bits = ((unsigned)(ex + 7) << 3) | ((unsigned)r - 8u);
  if (bits > 0x7e) bits = 0x7e; return sgn | bits; }
DI float emu_e4m32f(unsigned b) { const float sg = (b & 0x80u) ? -1.f : 1.f; const unsigned ex = (b >> 3) & 15u, m = b & 7u; if (ex == 0) return sg * ldexpf((float)m, -9); return sg * ldexpf((float)(8 + m), (int)ex - 10); }
DI unsigned enc_fp8x4(float a, float b, float c, float d) { return emu_f2e4m3(a) | (emu_f2e4m3(b) << 8) | (emu_f2e4m3(c) << 16) | (emu_f2e4m3(d) << 24); }
DI f32x2 dec_fp8_lo(unsigned w) { return (f32x2){emu_e4m32f(w & 0xff), emu_e4m32f((w >> 8) & 0xff)}; }
DI f32x2 dec_fp8_hi(unsigned w) { return (f32x2){emu_e4m32f((w >> 16) & 0xff), emu_e4m32f(w >> 24)}; }
#else
DI unsigned enc_fp8x4(float a, float b, float c, float d) { int r = __builtin_amdgcn_cvt_pk_fp8_f32(a, b, 0, false); r = __builtin_amdgcn_cvt_pk_fp8_f32(c, d, r, true); return (unsigned)r; }
DI f32x2 dec_fp8_lo(unsigned w) { return __builtin_amdgcn_cvt_pk_f32_fp8((int)w, false); }
DI f32x2 dec_fp8_hi(unsigned w) { return __builtin_amdgcn_cvt_pk_f32_fp8((int)w, true); }
#endif
DI float wave_sum(float v) { for (int m = 32; m >= 1; m >>= 1) v += __shfl_xor(v, m); return v; }
DI f32x4 mfma16(bf16x8 a, bf16x8 b, f32x4 c) { return __builtin_amdgcn_mfma_f32_16x16x32_bf16(a, b, c, 0, 0, 0); }
DI f32x16 mfma32(bf16x8 a, bf16x8 b, f32x16 c) { return __builtin_amdgcn_mfma_f32_32x32x16_bf16(a, b, c, 0, 0, 0); }
DI int crow(int i, int h) { return (i & 3) + 8 * (i >> 2) + 4 * h; }
DI f32x16 zero16() { f32x16 z; for (int i = 0; i < 16; ++i) z[i] = 0.f; return z; }

constexpr size_t al256(size_t x) { return (x + 255) & ~(size_t)255; }
struct WsLayout {
  size_t bar, uinv, vinv, W1T, W2T, WquT, WkvT, WnT, WmT, WoT, WpqT, SK, U16, V16, cmpbias, ropeN, ropeM, mod, ovlT;
  size_t WinT, h, on, om, h2;
  size_t Qn, KcR, VcR, Ks, Kw, VsT, VwT, gn, cq, ckv, kr, cqpart, ckvpart, merged, qry, yb, pw, ypart2;
  size_t Qm, Km, VmT, hid, Kc, VcT, y, ypart, sc, apart;
  size_t picks;
  size_t total;
};
constexpr WsLayout make_layout() {
  WsLayout L{}; size_t o = 0;
  auto take = [&](size_t bytes) { size_t r = o; o = al256(o + bytes); return r; };
  L.bar = take(16384);
  L.uinv = take((size_t)NEXP * 4); L.vinv = take((size_t)NEXP * 4);
  L.W1T = take((size_t)2 * CMP_HIDDEN * 2048 * 2);
  L.W2T = take((size_t)2 * 128 * CMP_HIDDEN * 2);
  L.WquT = take((size_t)NH * MQK * QR * 2);
  L.WkvT = take((size_t)NH * 128 * KVR * 2);
  L.WnT = take((size_t)D_MODEL * 1024 * 2);
  L.WmT = take((size_t)D_MODEL * 1024 * 2);
  L.WoT = take((size_t)D_MODEL * D_MODEL * 2);
  L.WpqT = take((size_t)2048 * D_MODEL * 2);
  L.SK = take((size_t)16 * 128 * 128 * 2);
  L.U16 = take((size_t)NEXP * D_MODEL * 2);
  L.V16 = take((size_t)NEXP * D_MODEL * 2);
  L.cmpbias = take(2 * CMP_HIDDEN * 4);
  L.ropeN = take((size_t)NTOK * 16 * 4);
  L.ropeM = take((size_t)NTOK * 32 * 4);
  L.mod = take((size_t)BATCH * 6 * D_MODEL * 4);
  L.ovlT = take((size_t)64 * NCP * 2 + 4096);
  size_t r1 = o;
  L.WinT = take((size_t)NPROJ * D_MODEL * 2);
  L.h = take((size_t)NTOK * D_MODEL * 2);
  size_t r1end = o;
  o = r1; L.on = take((size_t)NTOK * 1024 * 2); L.om = take((size_t)NTOK * 1024 * 2);
  if (o > r1end) r1end = o;
  o = r1; L.h2 = take((size_t)NTOK * D_MODEL * 2);
  if (o > r1end) r1end = o;
  o = r1end;
  size_t r2 = o;
  L.Qn = take((size_t)NTOK * 1024 * 2);
  L.KcR = take((size_t)NTOK * 256 * 2 + 8192);
  L.VcR = take((size_t)NTOK * 256 * 2 + 8192);
  L.Ks = take((size_t)NTOK * 256 * 2);
  L.Kw = take((size_t)NTOK * 256 * 2);
  L.VsT = take((size_t)NTOK * 256 * 2);
  L.VwT = take((size_t)NTOK * 256 * 2);
  L.gn = take((size_t)NTOK * 48 * 4);
  L.cq = take((size_t)NTOK * QR * 2);
  L.ckv = take((size_t)NTOK * KVR * 2);
  L.kr = take((size_t)NTOK * 32 * 4);
  L.cqpart = take((size_t)16 * NTOK * 4);
  L.ckvpart = take((size_t)8 * NTOK * 4);
  size_t r2end = o;
  o = r2; L.merged = take((size_t)NTOK * D_MODEL * 2); if (o > r2end) r2end = o;
  o = r2; L.qry = take((size_t)NTOK * 2048 * 2); if (o > r2end) r2end = o;
  o = r2; L.yb = take((size_t)NTOK * D_MODEL * 2); L.pw = take((size_t)NTOK * NPICK * 4); L.ypart2 = take((size_t)(D_MODEL / 128) * NTOK * 4); if (o > r2end) r2end = o;
  o = r2end;
  size_t r3 = o;
  L.Qm = take((size_t)NTOK * NH * MQK * 2);
  L.Km = take((size_t)NTOK * NH * MQK * 2);
  L.VmT = take((size_t)NTOK * NH * 64 * 2);
  L.hid = take((size_t)2 * BATCH * NG * NCP * CMP_HIDDEN * 2);
  L.Kc = take((size_t)BATCH * NG * NCP * 64 * 2 + 16384);
  L.VcT = take((size_t)BATCH * NG * 64 * NCP * 2 + 16384);
  size_t r3end = o;
  o = r3; L.y = take((size_t)NTOK * D_MODEL * 2); L.ypart = take((size_t)(D_MODEL / 128) * NTOK * 4); if (o > r3end) r3end = o;
  o = r3; L.sc = take((size_t)NTOK * 2048 * 4); if (o > r3end) r3end = o;
  o = r3; L.apart = take((size_t)(D_MODEL / 128) * NTOK * NPICK * 2); if (o > r3end) r3end = o;
  o = r3end;
  L.picks = take((size_t)NTOK * NPICK * 8);
  L.total = o;
  return L;
}
constexpr WsLayout WL = make_layout();

struct Params {
  const float *x, *c; const int* pos;
  const float *ada_w, *ada_b, *attn_pre_g, *attn_post_g, *w_in, *cmp_pe, *cmp_w1, *cmp_b1, *cmp_w2, *mla_q_norm_g, *mla_w_q_up,
      *mla_kv_norm_g, *mla_w_kv_up, *w_branch_nsa, *w_branch_mla, *w_out, *ffn_pre_g, *ffn_post_g, *peer_w_q, *peer_sub_keys, *peer_u, *peer_v;
  float* out; char* ws;
};
#define WSP(T, name) ((T*)(p.ws + WL.name))

#ifdef HOST_EMU
DI void glds16(const void* g, char* lds_wave_base) { __builtin_memcpy(lds_wave_base + (tid() & 63) * 16, g, 16); }
#else
DI void glds16(const void* g, char* lds_wave_base) { __builtin_amdgcn_global_load_lds((const unsigned*)g, (unsigned*)lds_wave_base, 16, 0, 0); }
#endif
#ifdef HOST_EMU
#define SCHED_FENCE() do {} while (0)
DI void wait_vm4() {} DI void wait_vm0() {} DI void raw_barrier() { __syncthreads(); }
#else
#define SCHED_FENCE() __builtin_amdgcn_sched_barrier(0)
DI void wait_vm4() { asm volatile("s_waitcnt vmcnt(4)" ::: "memory"); }
DI void wait_vm0() { asm volatile("s_waitcnt vmcnt(0)" ::: "memory"); }
DI void raw_barrier() { asm volatile("s_waitcnt lgkmcnt(0)" ::: "memory"); __builtin_amdgcn_s_barrier(); asm volatile("" ::: "memory"); }
#endif
struct GemmAcc { f32x16 a[4][2]; };
template <int GV> DI f32x16 mfmaV(bf16x8 a, bf16x8 b, f32x16 c) { if (GV & 2) { c[0] += __builtin_bit_cast(float, (int)a[0] + (int)b[0]); return c; } return mfma32(a, b, c); }
template <int GV = 0  > DI void gemm_mainloop(const bf16_t* Ap, long lda, int mrows  , const bf16_t* Bp, long ldb, int nrows  , int K, char* lds, GemmAcc& G) {
  const int t = tid(), w = t >> 6, l = t & 63, wm = w >> 2, wn = w & 3, lr = l & 31, lh = l >> 5;
#pragma unroll
  for (int i = 0; i < 4; ++i)
#pragma unroll
    for (int j = 0; j < 2; ++j) G.a[i][j] = zero16();
  const int nk = K >> 5;
  constexpr int TA = 256 * 64, SB = 2 * TA;
  const bf16_t* ag[2]; const bf16_t* bgp[2];
#pragma unroll
  for (int i = 0; i < 2; ++i) { const int row = 32 * w + 16 * i + (l >> 2); const int c = (l & 3) ^ ((row >> 2) & 3);
    const int ra = row < mrows ? row : mrows - 1, rb = row < nrows ? row : nrows - 1; ag[i] = Ap + (long)ra * lda + c * 8; bgp[i] = Bp + (long)rb * ldb + c * 8; }
  char* s0 = lds; char* s1 = lds + SB; char* s2 = lds + 2 * SB;
#pragma unroll
  for (int pre = 0; pre < 2; ++pre) { char* sb = (pre ? s1 : s0) + (2 * w) * 1024; const int kc = pre < nk ? pre : nk - 1;
#pragma unroll
    for (int i = 0; i < 2; ++i) { if (!(GV & 1)) { glds16(ag[i] + kc * 32, sb + i * 1024); glds16(bgp[i] + kc * 32, sb + TA + i * 1024); } } }
  const int arow = wm * 128 + lr, brow = wn * 64 + lr;
  const int asw = (arow >> 2) & 3, bsw = (brow >> 2) & 3;
  const int ca0 = ((0 + lh) ^ asw) << 4, ca1 = ((2 + lh) ^ asw) << 4, cb0 = ((0 + lh) ^ bsw) << 4, cb1 = ((2 + lh) ^ bsw) << 4;
  for (int kt = 0; kt < nk; ++kt) {
    wait_vm4();
    raw_barrier();
    const char* const cA = s0; const char* const cB = cA + TA;
    const int kn = kt + 2 < nk ? kt + 2 : nk - 1;
    const int ko = kn * 32; char* const nsA = s2 + (2 * w) * 1024; char* const nsB = nsA + TA;
    bf16x8 a0[4], a1[4];
    const bf16x8 b00 = *(const bf16x8*)(cB + brow * 64 + cb0), b01 = *(const bf16x8*)(cB + (brow + 32) * 64 + cb0);
#pragma unroll
    for (int mi = 0; mi < 4; ++mi) a0[mi] = *(const bf16x8*)(cA + (arow + 32 * mi) * 64 + ca0);
    const bf16x8 b10 = *(const bf16x8*)(cB + brow * 64 + cb1), b11 = *(const bf16x8*)(cB + (brow + 32) * 64 + cb1);
#pragma unroll
    for (int mi = 0; mi < 4; ++mi) a1[mi] = *(const bf16x8*)(cA + (arow + 32 * mi) * 64 + ca1);
    SCHED_FENCE();
    G.a[0][0] = mfmaV<GV>(a0[0], b00, G.a[0][0]); G.a[0][1] = mfmaV<GV>(a0[0], b01, G.a[0][1]); SCHED_FENCE(); if (!(GV & 1)) glds16(ag[0] + ko, nsA); SCHED_FENCE();
    G.a[1][0] = mfmaV<GV>(a0[1], b00, G.a[1][0]); G.a[1][1] = mfmaV<GV>(a0[1], b01, G.a[1][1]);
    G.a[2][0] = mfmaV<GV>(a0[2], b00, G.a[2][0]); G.a[2][1] = mfmaV<GV>(a0[2], b01, G.a[2][1]); SCHED_FENCE(); if (!(GV & 1)) glds16(ag[1] + ko, nsA + 1024); SCHED_FENCE();
    G.a[3][0] = mfmaV<GV>(a0[3], b00, G.a[3][0]); G.a[3][1] = mfmaV<GV>(a0[3], b01, G.a[3][1]);
    G.a[0][0] = mfmaV<GV>(a1[0], b10, G.a[0][0]); G.a[0][1] = mfmaV<GV>(a1[0], b11, G.a[0][1]); SCHED_FENCE(); if (!(GV & 1)) glds16(bgp[0] + ko, nsB); SCHED_FENCE();
    G.a[1][0] = mfmaV<GV>(a1[1], b10, G.a[1][0]); G.a[1][1] = mfmaV<GV>(a1[1], b11, G.a[1][1]);
    G.a[2][0] = mfmaV<GV>(a1[2], b10, G.a[2][0]); G.a[2][1] = mfmaV<GV>(a1[2], b11, G.a[2][1]); SCHED_FENCE(); if (!(GV & 1)) glds16(bgp[1] + ko, nsB + 1024); SCHED_FENCE();
    G.a[3][0] = mfmaV<GV>(a1[3], b10, G.a[3][0]); G.a[3][1] = mfmaV<GV>(a1[3], b11, G.a[3][1]);
    SCHED_FENCE();
    char* const tmp = s0; s0 = s1; s1 = s2; s2 = tmp;
  }
  wait_vm0();
  raw_barrier();
}
namespace g8 {
constexpr int BK = 64, HALF = 128, HT = HALF * BK;
DI int lds_byte(int r, int c) { const int st = (r >> 4) * 2 + (c >> 5), rr = r & 15, cc = c & 31, ob = rr * 64 + cc * 2; return st * 1024 + (ob ^ (((ob >> 9) & 1) << 5)); }
DI void stage_rc(int b, int& R, int& C) { const int st = b / 1024, sb = b % 1024, swz = sb ^ (((sb >> 9) & 1) << 5); R = (st >> 1) * 16 + swz / 64; C = (st & 1) * 32 + (swz % 64) / 2; }
}
#ifdef HOST_EMU
#define G8_WAIT_V(n) do {} while (0)
#define G8_WAIT_L(n) do {} while (0)
#define G8_BAR __syncthreads()
#define G8_SCHED do {} while (0)
#define G8_PRIO(x) do {} while (0)
#else
#define G8_WAIT_V(n) asm volatile("s_waitcnt vmcnt(" #n ")" ::: "memory")
#define G8_WAIT_L(n) asm volatile("s_waitcnt lgkmcnt(" #n ")" ::: "memory")
#define G8_BAR __builtin_amdgcn_s_barrier()
#define G8_SCHED __builtin_amdgcn_sched_barrier(0)
#define G8_PRIO(x) __builtin_amdgcn_s_setprio(x)
#endif
struct GemmAcc8 { f32x4 a[2][2][4][2]; };
struct NoMid { DI void operator()(GemmAcc8&) const {} };
template <bool SPLIT = false, class MidF = NoMid> DI void gemm_mainloop8(const bf16_t* A, long lda, int mrows, const bf16_t* Bt, long ldb, int nrows, int K, char* lds, GemmAcc8& G,
                                                                        const bf16_t* A2 = nullptr, const bf16_t* Bt2 = nullptr, int ksplit = 0, MidF mid = MidF()) {
  using namespace g8;
  bf16_t* shm = (bf16_t*)lds;
  const int tx = tid(); const int wid = tx >> 6, lane = tx & 63, wr = wid >> 2, wc = wid & 3, fr = lane & 15, fq = lane >> 4;
#define G8_SA(b, h) (shm + ((b) * 2 + (h)) * HT)
#define G8_SB(b, h) (shm + (4 + (b) * 2 + (h)) * HT)
  unsigned oA[2], oB[2];
#pragma unroll
  for (int i = 0; i < 2; ++i) { int r_, c_; stage_rc(tx * 16 + i * 8192, r_, c_); oA[i] = (unsigned)(r_ * (int)lda + c_) * 2u; oB[i] = (unsigned)(r_ * (int)ldb + c_) * 2u; }
  const int wbase = __builtin_amdgcn_readfirstlane((tx & ~63) * 16);
#define G8_STAGE(P, BASE, LD, br, OFF, kt) do { const bf16_t* _ub = ((SPLIT && (kt) >= ksplit) ? ((BASE) == A ? A2 : Bt2) + (long)((kt) - ksplit) * BK : (BASE) + (long)(kt) * BK) + (long)(br) * (LD); _Pragma("unroll") for (int _i = 0; _i < 2; ++_i) \
    glds16((const char*)_ub + OFF[_i], (char*)(P) + wbase + _i * 8192); } while (0)
#define G8_LDA(dst, b, h) _Pragma("unroll") for (int m = 0; m < 4; ++m) _Pragma("unroll") for (int k = 0; k < 2; ++k) \
    dst[m][k] = *(const bf16x8*)((const char*)G8_SA(b, h) + lds_byte(wr * 64 + m * 16 + fr, k * 32 + fq * 8))
#define G8_LDB(dst, b, h) _Pragma("unroll") for (int n = 0; n < 2; ++n) _Pragma("unroll") for (int k = 0; k < 2; ++k) \
    dst[n][k] = *(const bf16x8*)((const char*)G8_SB(b, h) + lds_byte(wc * 32 + n * 16 + fr, k * 32 + fq * 8))
#define G8_MMA(ai, bj, At, Bq) do { G8_PRIO(1); _Pragma("unroll") for (int m = 0; m < 4; ++m) _Pragma("unroll") for (int n = 0; n < 2; ++n) _Pragma("unroll") for (int k = 0; k < 2; ++k) \
    G.a[ai][bj][m][n] = mfma16(Bq[n][k], At[m][k], G.a[ai][bj][m][n]); G8_PRIO(0); } while (0)
#pragma unroll
  for (int ai = 0; ai < 2; ++ai)
#pragma unroll
    for (int bj = 0; bj < 2; ++bj)
#pragma unroll
      for (int m = 0; m < 4; ++m)
#pragma unroll
        for (int n = 0; n < 2; ++n) G.a[ai][bj][m][n] = (f32x4){0.f, 0.f, 0.f, 0.f};
  bf16x8 At[4][2], B0[2][2], B1[2][2];
  const int nt = K / BK;
  G8_STAGE(G8_SB(0, 0), Bt, ldb, 0, oB, 0); G8_STAGE(G8_SA(0, 0), A, lda, 0, oA, 0);
  G8_STAGE(G8_SB(0, 1), Bt, ldb, HALF, oB, 0); G8_STAGE(G8_SA(0, 1), A, lda, HALF, oA, 0);
  if (wr == 1) G8_BAR;
  G8_WAIT_V(4); G8_BAR;
  G8_STAGE(G8_SB(1, 0), Bt, ldb, 0, oB, 1); G8_STAGE(G8_SA(1, 0), A, lda, 0, oA, 1); G8_STAGE(G8_SB(1, 1), Bt, ldb, HALF, oB, 1);
  G8_WAIT_V(6); G8_BAR;
  for (int t = 0; t < nt - 2; t += 2) {
    G8_LDB(B0, 0, 0); G8_SCHED; G8_LDA(At, 0, 0); G8_STAGE(G8_SA(1, 1), A, lda, HALF, oA, t + 1);
    G8_WAIT_L(8); G8_BAR; G8_WAIT_L(0); G8_MMA(0, 0, At, B0); G8_BAR; G8_SCHED;
    G8_LDB(B1, 0, 1); G8_STAGE(G8_SB(0, 0), Bt, ldb, 0, oB, t + 2);
    G8_BAR; G8_WAIT_L(0); G8_MMA(0, 1, At, B1); G8_BAR;
    G8_LDA(At, 0, 1); G8_STAGE(G8_SA(0, 0), A, lda, 0, oA, t + 2);
    G8_BAR; G8_WAIT_L(0); G8_MMA(1, 0, At, B0); G8_BAR; G8_SCHED;
    G8_STAGE(G8_SB(0, 1), Bt, ldb, HALF, oB, t + 2);
    G8_WAIT_V(6); G8_BAR; G8_MMA(1, 1, At, B1); G8_BAR;
    G8_LDB(B0, 1, 0); G8_SCHED; G8_LDA(At, 1, 0); G8_STAGE(G8_SA(0, 1), A, lda, HALF, oA, t + 2);
    G8_WAIT_L(8); G8_BAR; G8_WAIT_L(0); G8_MMA(0, 0, At, B0); G8_BAR; G8_SCHED;
    G8_LDB(B1, 1, 1); G8_STAGE(G8_SB(1, 0), Bt, ldb, 0, oB, t + 3);
    G8_BAR; G8_WAIT_L(0); G8_MMA(0, 1, At, B1); G8_BAR;
    G8_LDA(At, 1, 1); G8_STAGE(G8_SA(1, 0), A, lda, 0, oA, t + 3);
    G8_BAR; G8_WAIT_L(0); G8_MMA(1, 0, At, B0); G8_BAR; G8_SCHED;
    G8_STAGE(G8_SB(1, 1), Bt, ldb, HALF, oB, t + 3);
    G8_WAIT_V(6); G8_BAR; G8_MMA(1, 1, At, B1); G8_BAR;
    if (SPLIT && t + 2 == ksplit) mid(G);
  }
  { G8_LDB(B0, 0, 0); G8_LDA(At, 0, 0); G8_STAGE(G8_SA(1, 1), A, lda, HALF, oA, nt - 1);
    G8_BAR; G8_WAIT_L(0); G8_MMA(0, 0, At, B0); G8_BAR;
    G8_LDB(B1, 0, 1); G8_BAR; G8_WAIT_L(0); G8_MMA(0, 1, At, B1); G8_BAR;
    G8_LDA(At, 0, 1); G8_WAIT_V(4); G8_BAR; G8_WAIT_L(0); G8_MMA(1, 0, At, B0); G8_MMA(1, 1, At, B1); G8_BAR; }
  { G8_LDB(B0, 1, 0); G8_LDA(At, 1, 0); G8_WAIT_V(2); G8_BAR; G8_WAIT_L(0); G8_MMA(0, 0, At, B0); G8_BAR;
    G8_LDB(B1, 1, 1); G8_WAIT_V(0); G8_BAR; G8_WAIT_L(0); G8_MMA(0, 1, At, B1); G8_BAR;
    G8_LDA(At, 1, 1); G8_BAR; G8_WAIT_L(0); G8_MMA(1, 0, At, B0); G8_MMA(1, 1, At, B1); G8_BAR; }
  if (wr == 0) G8_BAR;
  __syncthreads();
}
DI void gemm_stage_quarter8(const GemmAcc8& G, int ai, int bj, char* lds) {
  const int tx = tid(); const int wid = tx >> 6, lane = tx & 63, wr = wid >> 2, wc = wid & 3, fr = lane & 15, fq = lane >> 4;
  float* st = (float*)lds;
#pragma unroll
  for (int m = 0; m < 4; ++m)
#pragma unroll
    for (int n = 0; n < 2; ++n)
#pragma unroll
      for (int j = 0; j < 4; ++j) st[(wr * 64 + m * 16 + fr) * ST_LD + wc * 32 + n * 16 + fq * 4 + j] = G.a[ai][bj][m][n][j];
  __syncthreads();
}
template <class EpiD> DI void gemm_direct_quarter8(const GemmAcc8& G, int ai, int bj, int row0, EpiD epid) {
  const int tx = tid(); const int wid = tx >> 6, lane = tx & 63, wr = wid >> 2, wc = wid & 3, fr = lane & 15, fq = lane >> 4;
#pragma unroll
  for (int m = 0; m < 4; ++m) epid(row0 + wr * 64 + m * 16 + fr, wc * 32 + fq * 4, G.a[ai][bj][m][0], G.a[ai][bj][m][1]);
}
template <class Sel, class Epi, class EpiD> DI void gemm_tile8(const bf16_t* A, long lda, int M, int m0, const bf16_t* Bp, long ldb, int ncols, int K, char* lds, Sel direct, Epi epi, EpiD epid) {
  GemmAcc8 G; gemm_mainloop8(A + (long)m0 * lda, lda, M - m0, Bp, ldb, ncols, K, lds, G);
#pragma unroll
  for (int hm = 0; hm < 2; ++hm)
#pragma unroll
    for (int hn = 0; hn < 2; ++hn) { if (m0 + hm * 128 < M && hn * 128 < ncols) {
        if (direct(hn)) gemm_direct_quarter8(G, hm, hn, m0 + hm * 128, [&](int row, int col, const f32x4& v0, const f32x4& v1) __attribute__((always_inline)) { epid(row, col, v0, v1, hn * 128); });
        else { gemm_stage_quarter8(G, hm, hn, lds); epi((const float*)lds, m0 + hm * 128, hn * 128); __syncthreads(); } } }
}

DI void gemm_stage_quarter(const GemmAcc& G, int hm, int hn, char* lds) {
  const int t = tid(), w = t >> 6, l = t & 63, wm = w >> 2, wn = w & 3, lr = l & 31, lh = l >> 5;
  float* st = (float*)lds;
  if (wm == hm && (wn >> 1) == hn) {
#pragma unroll
    for (int mi = 0; mi < 4; ++mi)
#pragma unroll
      for (int ni = 0; ni < 2; ++ni)
#pragma unroll
        for (int i = 0; i < 16; ++i) st[(mi * 32 + crow(i, lh)) * ST_LD + (wn & 1) * 64 + ni * 32 + lr] = G.a[mi][ni][i];
  }
  __syncthreads();
}
template <int GV = 0, class Epi> DI void gemm_tile(const bf16_t* A, long lda, int M, int m0, const bf16_t* Bp, long ldb, int ncols  , int K, char* lds, Epi epi) {
  GemmAcc G; gemm_mainloop<GV>(A + (long)m0 * lda, lda, M - m0, Bp, ldb, ncols, K, lds, G);
#pragma unroll
  for (int hm = 0; hm < 2; ++hm)
#pragma unroll
    for (int hn = 0; hn < 2; ++hn) { if (m0 + hm * 128 < M && hn * 128 < ncols) { gemm_stage_quarter(G, hm, hn, lds); epi((const float*)lds, m0 + hm * 128, hn * 128); } __syncthreads(); }
}

template <class GateF, class StoreF> DI void gemm_tile8_merge(const bf16_t* A1, const bf16_t* B1, const bf16_t* A2, const bf16_t* B2, long ld, int m0, int K1, char* lds, GateF gates, StoreF store) {
  GemmAcc8 G;
  auto lanepos = [&](int& row, int& col, int ai, int bj, int m, int n) __attribute__((always_inline)) { const int tx = tid(); const int wid = tx >> 6, lane = tx & 63, wr = wid >> 2, wc = wid & 3, fr = lane & 15, fq = lane >> 4;
    row = m0 + ai * 128 + wr * 64 + m * 16 + fr; col = bj * 128 + wc * 32 + n * 16 + fq * 4; };
  auto mid = [&](GemmAcc8& Gm) __attribute__((always_inline)) {
#pragma unroll
    for (int ai = 0; ai < 2; ++ai)
#pragma unroll
      for (int bj = 0; bj < 2; ++bj)
#pragma unroll
        for (int m = 0; m < 4; ++m)
#pragma unroll
          for (int n = 0; n < 2; ++n) { int row, col; lanepos(row, col, ai, bj, m, n); f32x4 g0, g1; gates(row, col, g0, g1);
#pragma unroll
            for (int j = 0; j < 4; ++j) Gm.a[ai][bj][m][n][j] *= g0[j] * frcp(g1[j]); } };
  gemm_mainloop8<true>(A1 + (long)m0 * ld, ld, 256, B1, ld, 256, 2 * K1, lds, G, A2 + (long)m0 * ld, B2, K1 / 64, mid);
#pragma unroll
  for (int ai = 0; ai < 2; ++ai)
#pragma unroll
    for (int bj = 0; bj < 2; ++bj)
#pragma unroll
      for (int m = 0; m < 4; ++m)
#pragma unroll
        for (int n = 0; n < 2; ++n) { int row, col; lanepos(row, col, ai, bj, m, n); f32x4 g0, g1; gates(row, col, g0, g1); store(row, col, G.a[ai][bj][m][n] * g1); }
}

DI float rope_n(const float* st, int row, int c, const float* rt  ) {
  const int d = c & 63; const float xv = st[row * ST_LD + c];
  if (d >= 16) return xv;
  const int i = d & 7; const float cs = rt[i], sn = rt[8 + i];
  if (d < 8) return xv * cs - st[row * ST_LD + c + 8] * sn;
  return xv * cs + st[row * ST_LD + c - 8] * sn;
}

DI void epi_proj(const Params& p, const float* st, int m0, int n0) {
  const int t = tid(), w = t >> 6, l = t & 63, c = 2 * l;
  const int nt = n0 >> 7, b = m0 / SEQ, t0 = m0 % SEQ;
  const float* ropeN = WSP(const float, ropeN);
  if (nt < 8) {
    bf16_t* Qn = WSP(bf16_t, Qn);
    _Pragma("nounroll") for (int it = 0; it < 128 / NW; ++it) { const int row = it * NW + w; const long tok = m0 + row; const float* rt = ropeN + tok * 16;
      *(unsigned*)(Qn + tok * 1024 + n0 + c) = pack2(rope_n(st, row, c, rt), rope_n(st, row, c + 1, rt)); }
  } else if (nt < 20) {
    const int chunk = (nt - 8) >> 1, g = ((nt - 8) & 1) * 2 + (c >> 6), d = c & 63;
    if (chunk == 0 || chunk == 1 || chunk == 2 || chunk == 4) {
      bf16_t* dst = chunk == 0 ? WSP(bf16_t, KcR) : chunk == 1 ? WSP(bf16_t, VcR) : chunk == 2 ? WSP(bf16_t, Ks) : WSP(bf16_t, Kw);
      const bool rp = (chunk != 1);
      _Pragma("nounroll") for (int it = 0; it < 128 / NW; ++it) { const int row = it * NW + w; const long tok = m0 + row; const float* rt = ropeN + tok * 16;
        float v0, v1; if (rp) { v0 = rope_n(st, row, c, rt); v1 = rope_n(st, row, c + 1, rt); } else { v0 = st[row * ST_LD + c]; v1 = st[row * ST_LD + c + 1]; }
        *(unsigned*)(dst + (((long)(b * NG + g) * SEQ + t0 + row) * 64 + d)) = pack2(v0, v1); }
    } else {
      bf16_t* dst = chunk == 3 ? WSP(bf16_t, VsT) : WSP(bf16_t, VwT);
      _Pragma("nounroll") for (int it = 0; it < 128 / NW; ++it) { const int col = it * NW + w; const int gg = ((nt - 8) & 1) * 2 + (col >> 6), dd = col & 63;
        *(unsigned*)(dst + ((long)((b * NG + gg) * 64 + dd) * SEQ + t0 + 2 * l)) = pack2(st[(2 * l) * ST_LD + col], st[(2 * l + 1) * ST_LD + col]); }
    }
  } else if (nt < 26) {
    const bool isq = nt < 24; const int j = isq ? nt - 20 : nt - 24; const int ld = isq ? QR : KVR;
    bf16_t* dst = isq ? WSP(bf16_t, cq) : WSP(bf16_t, ckv); float* part = isq ? WSP(float, cqpart) : WSP(float, ckvpart);
    _Pragma("nounroll") for (int it = 0; it < 128 / NW; ++it) { const int row = it * NW + w; const long tok = m0 + row;
      *(unsigned*)(dst + tok * ld + j * 128 + c) = pack2(st[row * ST_LD + c], st[row * ST_LD + c + 1]); }
    if (t < 128) { float sq = 0.f;
#pragma unroll 8
      for (int cc = 0; cc < 128; ++cc) { const float v = st[t * ST_LD + cc]; sq += v * v; }
      part[(long)j * NTOK + m0 + t] = sq; }
  } else if (nt < NT_LAST) {
    bf16_t* gm = (bf16_t*)p.out;
    _Pragma("nounroll") for (int it = 0; it < 128 / NW; ++it) { const int row = it * NW + w; const long tok = m0 + row;
      *(unsigned*)(gm + tok * (2 * D_MODEL) + (nt - 26) * 128 + c) = pack2(fsigmoid(st[row * ST_LD + c]), fsigmoid(st[row * ST_LD + c + 1])); }
  } else {
    float* kr = WSP(float, kr); float* gn = WSP(float, gn); const float* ropeM = WSP(const float, ropeM);
    _Pragma("nounroll") for (int it = 0; it < 128 / NW; ++it) { const int row = it * NW + w; const long tok = m0 + row;
      if (l < 32) { const int i = l & 15; const float cs = ropeM[tok * 32 + i], sn = ropeM[tok * 32 + 16 + i]; const float x1 = st[row * ST_LD + i], x2 = st[row * ST_LD + 16 + i];
        kr[tok * 32 + l] = (l < 16) ? x1 * cs - x2 * sn : x2 * cs + x1 * sn; }
      if (l < 48) gn[tok * 48 + l] = fsigmoid(st[row * ST_LD + 32 + l]); }
  }
}

DI void epi_cmp1(const Params& p, const float* st, int m0, int n0, int which) {
  const int t = tid(), w = t >> 6, l = t & 63, c = 2 * l;
  const float* bias = WSP(const float, cmpbias) + which * CMP_HIDDEN; bf16_t* hid = WSP(bf16_t, hid) + (size_t)which * BATCH * NG * NCP * CMP_HIDDEN;
  const float b0 = bias[n0 + c], b1 = bias[n0 + c + 1];
  _Pragma("nounroll") for (int it = 0; it < 128 / NW; ++it) { const int row = it * NW + w;
    *(unsigned*)(hid + (long)(m0 + row) * CMP_HIDDEN + n0 + c) = pack2(fgelu_tanh(st[row * ST_LD + c] + b0), fgelu_tanh(st[row * ST_LD + c + 1] + b1)); }
}
DI void epi_cmp2(const Params& p, const float* st, int m0, int which) {
  const int t = tid(), w = t >> 6, l = t & 63;
  if (which == 0) { bf16_t* Kc = WSP(bf16_t, Kc); const int c = 2 * l;
    if (l < 32) _Pragma("nounroll") for (int it = 0; it < 128 / NW; ++it) { const int row = it * NW + w; const int m = m0 + row; const bool bad = (m % NCP) == NCP - 1;
      *(unsigned*)(Kc + (long)m * 64 + c) = bad ? 0u : pack2(st[row * ST_LD + c], st[row * ST_LD + c + 1]); }
  } else { bf16_t* VcT = WSP(bf16_t, VcT);
    _Pragma("nounroll") for (int it = 0; it < 64 / NW; ++it) { const int d = it * NW + w;
      for (int half = 0; half < 2; ++half) { const int row = 2 * l + half; const int m = m0 + row; const int bg = m / NCP, n = m % NCP; const bool bad = n == NCP - 1;
        VcT[((long)bg * 64 + d) * NCP + n] = bad ? (bf16_t)0 : f2bf(st[row * ST_LD + d]); } }
  }
}
DI float row_rstd(const float* part, int nparts, long tok, int dim) { float s = 0.f; for (int j = 0; j < nparts; ++j) s += part[(long)j * NTOK + tok]; return frsq(s / (float)dim + NORM_EPS); }

constexpr int RS_OFF = 131072;
DI void tile_rstd(const float* part, int nparts, int m0, int dim, char* lds) { const int t = tid(); __syncthreads();
  if (t < 256) ((float*)(lds + RS_OFF))[t] = row_rstd(part, nparts, m0 + t, dim); }
DI void epi_qup(const Params& p, const float* st, int m0, int n0) {
  const int t = tid(), w = t >> 6, l = t & 63, c = 2 * l;
  bf16_t* Qm = WSP(bf16_t, Qm); const float* ropeM = WSP(const float, ropeM); const float* part = WSP(const float, cqpart);
  const int col = n0 + c, dd = col % MQK;
  const float* rsl = (const float*)((const char*)st + RS_OFF) + (m0 & 255);
  _Pragma("nounroll") for (int it = 0; it < 128 / NW; ++it) { const int row = it * NW + w; const long tok = m0 + row; const float rs = rsl[row];
    float v0 = st[row * ST_LD + c], v1 = st[row * ST_LD + c + 1];
    if (dd >= 64) { const int i = dd - 64; const float* rt = ropeM + tok * 32;
      if (i < 16) { const float p0 = st[row * ST_LD + c + 16], p1 = st[row * ST_LD + c + 17]; v0 = v0 * rt[i] - p0 * rt[16 + i]; v1 = v1 * rt[i + 1] - p1 * rt[16 + i + 1]; }
      else { const int k = i - 16; const float p0 = st[row * ST_LD + c - 16], p1 = st[row * ST_LD + c - 15]; v0 = v0 * rt[k] + p0 * rt[16 + k]; v1 = v1 * rt[k + 1] + p1 * rt[16 + k + 1]; } }
    *(unsigned*)(Qm + tok * (NH * MQK) + col) = pack2(v0 * rs, v1 * rs); }
}
DI void epi_kvup(const Params& p, const float* st, int m0, int n0, char* lds) {
  const int t = tid(), w = t >> 6, l = t & 63, c = 2 * l;
  const int hd = n0 >> 7, b = m0 / SEQ, t0 = m0 % SEQ;
  bf16_t* Km = WSP(bf16_t, Km); bf16_t* VmT = WSP(bf16_t, VmT); const float* kr = WSP(const float, kr); const float* part = WSP(const float, ckvpart);
  const float* rsl = (const float*)(lds + RS_OFF) + (m0 & 255);
  { const int row = t >> 2, i = (t & 3) * 8; const float* src = kr + (long)(m0 + row) * 32 + i; const f32x4 x0 = *(const f32x4*)src, x1 = *(const f32x4*)(src + 4);
    *(u32x4*)(Km + ((long)(b * NH + hd) * SEQ + t0 + row) * MQK + 64 + i) = (u32x4){pack2(x0[0], x0[1]), pack2(x0[2], x0[3]), pack2(x1[0], x1[1]), pack2(x1[2], x1[3])}; }
  _Pragma("nounroll") for (int it = 0; it < 64 / NW; ++it) { const int row = (it * NW + w) * 2 + (l >> 5), ck = 2 * (l & 31); const float rs = rsl[row];
    bf16_t* dst = Km + ((long)(b * NH + hd) * SEQ + t0 + row) * MQK;
    *(unsigned*)(dst + ck) = pack2(st[row * ST_LD + ck] * rs, st[row * ST_LD + ck + 1] * rs); }
  _Pragma("nounroll") for (int it = 0; it < 64 / NW; ++it) { const int d = it * NW + w; const int col = 64 + d;
    *(unsigned*)(VmT + ((long)((b * NH + hd) * 64 + d) * SEQ + t0 + 2 * l)) = pack2(st[(2 * l) * ST_LD + col] * rsl[2 * l], st[(2 * l + 1) * ST_LD + col] * rsl[2 * l + 1]); }
}
DI void epi_merge(const Params& p, const float* st, int m0, int n0, int which) {
  const int t = tid(), w = t >> 6, l = t & 63, c = 2 * l;
  bf16_t* mg = WSP(bf16_t, merged); const bf16_t* gm = (const bf16_t*)p.out;
  _Pragma("nounroll") for (int it = 0; it < 128 / NW; ++it) { const int row = it * NW + w; const long tok = m0 + row;
    const unsigned g = *(const unsigned*)(gm + tok * (2 * D_MODEL) + which * D_MODEL + n0 + c);
    float v0 = bflo(g) * st[row * ST_LD + c], v1 = bfhi(g) * st[row * ST_LD + c + 1];
    unsigned* dst = (unsigned*)(mg + tok * D_MODEL + n0 + c);
    if (which == 1) { const unsigned prev = *dst; v0 += bflo(prev); v1 += bfhi(prev); }
    *dst = pack2(v0, v1); }
}
DI void epi_wout(const Params& p, const float* st, int m0, int n0) {
  const int t = tid(), w = t >> 6, l = t & 63, c = 2 * l;
  bf16_t* y = WSP(bf16_t, y);
  _Pragma("nounroll") for (int it = 0; it < 128 / NW; ++it) { const int row = it * NW + w; const long tok = m0 + row;
    *(unsigned*)(y + tok * D_MODEL + n0 + c) = pack2(st[row * ST_LD + c], st[row * ST_LD + c + 1]); }
}
DI void epi_pq(const Params& p, const float* st, int m0, int n0) {
  const int t = tid(), w = t >> 6, l = t & 63, c = 2 * l; bf16_t* q = WSP(bf16_t, qry);
  _Pragma("nounroll") for (int it = 0; it < 128 / NW; ++it) { const int row = it * NW + w; *(unsigned*)(q + (long)(m0 + row) * 2048 + n0 + c) = pack2(st[row * ST_LD + c], st[row * ST_LD + c + 1]); }
}
DI void epi_sc(const Params& p, const float* st, int m0, int n0) {
  const int t = tid(), w = t >> 6, l = t & 63, c = 2 * l; float* sc = WSP(float, sc);
  _Pragma("nounroll") for (int it = 0; it < 128 / NW; ++it) { const int row = it * NW + w; f32x2 v = {st[row * ST_LD + c], st[row * ST_LD + c + 1]}; *(f32x2*)(sc + (long)(m0 + row) * 2048 + n0 + c) = v; }
}

DI u32x2 pack4(const f32x4& v) { return (u32x2){pack2(v[0], v[1]), pack2(v[2], v[3])}; }
DI void epid_store_bf16(bf16_t* base, long ld, int row, int col, const f32x4& v0, const f32x4& v1) {
  bf16_t* dst = base + (long)row * ld + col; *(u32x2*)dst = pack4(v0); *(u32x2*)(dst + 16) = pack4(v1); }
DI void epid_qup(const Params& p, int row, int col, const f32x4& v0, const f32x4& v1, const char* lds) {
  const float rs = ((const float*)(lds + RS_OFF))[row & 255];
  f32x4 a = v0, b = v1;
  if ((col >> 5) % 3 == 2) { const float* rt = WSP(const float, ropeM) + (long)row * 32 + (col & 31); const f32x4 cs = *(const f32x4*)rt, sn = *(const f32x4*)(rt + 16);
    a = v0 * cs - v1 * sn; b = v1 * cs + v0 * sn; }
  epid_store_bf16(WSP(bf16_t, Qm), NH * MQK, row, col, a * rs, b * rs);
}
DI void epid_merge(const Params& p, int row, int col, const f32x4& v0, const f32x4& v1, int which) {
  bf16_t* mg = WSP(bf16_t, merged) + (long)row * D_MODEL + col; const bf16_t* gm = (const bf16_t*)p.out + (long)row * (2 * D_MODEL) + which * D_MODEL + col;
#pragma unroll
  for (int h = 0; h < 2; ++h) { const f32x4& v = h ? v1 : v0; const u32x2 g = *(const u32x2*)(gm + 16 * h);
    f32x4 r = {bflo(g[0]) * v[0], bfhi(g[0]) * v[1], bflo(g[1]) * v[2], bfhi(g[1]) * v[3]};
    if (which == 1) { const u32x2 pr = *(const u32x2*)(mg + 16 * h); r[0] += bflo(pr[0]); r[1] += bfhi(pr[0]); r[2] += bflo(pr[1]); r[3] += bfhi(pr[1]); }
    *(u32x2*)(mg + 16 * h) = pack4(r); } }
DI void epid_proj(const Params& p, int row, int col, const f32x4& v0, const f32x4& v1, int n0) {
  const int nt = n0 >> 7;
  if (nt < 26) {
    const bool isq = nt < 24; const int j = isq ? nt - 20 : nt - 24; const int ld = isq ? QR : KVR;
    epid_store_bf16(isq ? WSP(bf16_t, cq) : WSP(bf16_t, ckv), ld, row, j * 128 + col, v0, v1);
    float sq = v0[0] * v0[0] + v0[1] * v0[1] + v0[2] * v0[2] + v0[3] * v0[3] + v1[0] * v1[0] + v1[1] * v1[1] + v1[2] * v1[2] + v1[3] * v1[3];
    sq += __shfl_xor(sq, 16); sq += __shfl_xor(sq, 32);
    if ((tid() & 63) < 16) (isq ? WSP(float, cqpart) : WSP(float, ckvpart))[(long)(j * 4 + (col >> 5)) * NTOK + row] = sq;
  } else {
    bf16_t* gm = (bf16_t*)p.out + (long)row * (2 * D_MODEL) + (nt - 26) * 128 + col;
    const f32x4 s0 = {fsigmoid(v0[0]), fsigmoid(v0[1]), fsigmoid(v0[2]), fsigmoid(v0[3])}, s1 = {fsigmoid(v1[0]), fsigmoid(v1[1]), fsigmoid(v1[2]), fsigmoid(v1[3])};
    *(u32x2*)gm = pack4(s0); *(u32x2*)(gm + 16) = pack4(s1); }
}
DI void epid_cmp1(const Params& p, int row, int col, const f32x4& v0, const f32x4& v1, int which) {
  const float* bias = WSP(const float, cmpbias) + which * CMP_HIDDEN + col; bf16_t* hid = WSP(bf16_t, hid) + (size_t)which * BATCH * NG * NCP * CMP_HIDDEN + (long)row * CMP_HIDDEN + col;
  const f32x4 b0 = *(const f32x4*)bias, b1 = *(const f32x4*)(bias + 16);
  const f32x4 r0 = {fgelu_tanh(v0[0] + b0[0]), fgelu_tanh(v0[1] + b0[1]), fgelu_tanh(v0[2] + b0[2]), fgelu_tanh(v0[3] + b0[3])}, r1 = {fgelu_tanh(v1[0] + b1[0]), fgelu_tanh(v1[1] + b1[1]), fgelu_tanh(v1[2] + b1[2]), fgelu_tanh(v1[3] + b1[3])};
  *(u32x2*)hid = pack4(r0); *(u32x2*)(hid + 16) = pack4(r1); }

template <int DV> struct FlashAcc { f32x16 o[DV / 32]; float m, l; };
template <int DV> DI void flash_init(FlashAcc<DV>& a) { for (int i = 0; i < DV / 32; ++i) a.o[i] = zero16(); a.m = -1e30f; a.l = 0.f; }

template <int DQK> DI void load_q(bf16x8 (&qf)[DQK / 16], const bf16_t* qrow, int lh) {
#pragma unroll
  for (int kk = 0; kk < DQK / 16; ++kk) qf[kk] = *(const bf16x8*)(qrow + kk * 16 + lh * 8);
}

template <int DQK, int DV, class MaskF>
DI void flash_run(const bf16x8 (&qf)[DQK / 16], const bf16_t* Kp, long ldk, const bf16_t* Vp, const bf16_t* V2p, long ldv, int kt0, int kt1,
                  float scl, MaskF mask, FlashAcc<DV>& A, char* lds) {
  constexpr int KSTR = DQK * 2 + 16, VSTR = 136, KCH = DQK / 8;
  constexpr int KB = 64 * KSTR, VB = DV * VSTR;
  constexpr int NKCH = 64 * KCH, NVCH = DV * 8, NKC = (NKCH + NTHREADS - 1) / NTHREADS, NVC = (NVCH + NTHREADS - 1) / NTHREADS;
  const int t = tid(), l = t & 63, lr = l & 31, lh = l >> 5;
  char* const kb0 = lds; char* const kb1 = lds + KB; char* const vb0 = lds + 2 * KB; char* const vb1 = lds + 2 * KB + VB;
  u32x4 rk[NKC], rv[NVC], rk2[NKC], rv2[NVC];
  auto gload = [&](int kt, u32x4 (&rk_)[NKC], u32x4 (&rv_)[NVC]) __attribute__((always_inline)) { const int ktc = kt < kt1 ? kt : kt1 - 1;
#pragma unroll
    for (int i = 0; i < NKC; ++i) { const int cidx = t + NTHREADS * i, row = cidx / KCH, kc = cidx % KCH; if (NKCH % NTHREADS == 0 || cidx < NKCH) rk_[i] = GLD16(Kp + (long)(ktc * 64 + row) * ldk + kc * 8); }
#pragma unroll
    for (int i = 0; i < NVC; ++i) { const int cidx = t + NTHREADS * i, d = cidx >> 3, kc = cidx & 7; const bf16_t* src = (DV > 64 && d >= 64) ? (V2p + (long)(d - 64) * ldv) : (Vp + (long)d * ldv); if (NVCH % NTHREADS == 0 || cidx < NVCH) rv_[i] = GLD16(src + ktc * 64 + kc * 8); }
  };
  auto lwrite = [&](int buf) __attribute__((always_inline)) { char* const kbw = buf ? kb1 : kb0; char* const vbw = buf ? vb1 : vb0;
#pragma unroll
    for (int i = 0; i < NKC; ++i) { const int cidx = t + NTHREADS * i, row = cidx / KCH, kc = cidx % KCH; if (NKCH % NTHREADS == 0 || cidx < NKCH) *(u32x4*)(kbw + row * KSTR + kc * 16) = rk[i]; }
#pragma unroll
    for (int i = 0; i < NVC; ++i) { const int cidx = t + NTHREADS * i, d = cidx >> 3, kc = cidx & 7; char* dst = vbw + d * VSTR + kc * 16;
      if (NVCH % NTHREADS == 0 || cidx < NVCH) { u32x2 lo = {rv[i][0], rv[i][1]}, hi = {rv[i][2], rv[i][3]}; *(u32x2*)dst = lo; *(u32x2*)(dst + 8) = hi; } }
  };
  if (kt0 >= kt1) return;
  gload(kt0, rk, rv); lwrite(0); gload(kt0 + 1, rk, rv); __syncthreads();
  for (int kt = kt0; kt < kt1; ++kt) {
    const int cur = (kt - kt0) & 1; const bool more = kt + 1 < kt1; const char* const kbc = cur ? kb1 : kb0; const char* const vbc = cur ? vb1 : vb0;
    gload(kt + 2, rk2, rv2);
    if (!mask.dead(kt)) {
    f32x16 s[2];
#pragma unroll
    for (int kbk = 0; kbk < 2; ++kbk) { s[kbk] = zero16();
#pragma unroll
      for (int kk = 0; kk < DQK / 16; ++kk) { bf16x8 a = *(const bf16x8*)(kbc + (kbk * 32 + lr) * KSTR + kk * 32 + lh * 16); s[kbk] = mfma32(a, qf[kk], s[kbk]); } }
    const bool tile_ok = mask.tile(kt);
    float mnew, alpha, rsum = 0.f;
    if (mask.interior(kt)) {
      float mr = -3e38f;
#pragma unroll
      for (int kbk = 0; kbk < 2; ++kbk)
#pragma unroll
        for (int i = 0; i < 16; i += 2) mr = fmaxf(fmaxf(mr, s[kbk][i]), s[kbk][i + 1]);
      mr = fmaxf(mr, __shfl_xor(mr, 32));
      const float sl = tile_ok ? scl : 0.f;
      const float mx = tile_ok ? mr * scl : -1e30f;
      mnew = fmaxf(A.m, mx); alpha = fexp2(A.m - mnew); A.m = mnew;
      const float nb = tile_ok ? -mnew : -2e30f;
#pragma unroll
      for (int kbk = 0; kbk < 2; ++kbk)
#pragma unroll
        for (int i = 0; i < 16; ++i) { const float pv = fexp2(__builtin_fmaf(s[kbk][i], sl, nb)); s[kbk][i] = pv; rsum += pv; }
    } else {
      const int hiL = tile_ok ? mask.hi(kt) : -1, loL = mask.lo(kt);
      float mx = -1e30f;
#pragma unroll
      for (int kbk = 0; kbk < 2; ++kbk)
#pragma unroll
        for (int i = 0; i < 16; ++i) { const int c = kbk * 32 + crow(i, lh); const bool ok = (c <= hiL) & (c > loL); const float v = ok ? s[kbk][i] * scl : -1e30f; s[kbk][i] = v; mx = fmaxf(mx, v); }
      mx = fmaxf(mx, __shfl_xor(mx, 32));
      mnew = fmaxf(A.m, mx); alpha = fexp2(A.m - mnew); A.m = mnew;
      const float msub = (mnew > -1e29f) ? mnew : 1e30f;
#pragma unroll
      for (int kbk = 0; kbk < 2; ++kbk)
#pragma unroll
        for (int i = 0; i < 16; ++i) { const float pv = fexp2(s[kbk][i] - msub); s[kbk][i] = pv; rsum += pv; }
    }
    rsum += __shfl_xor(rsum, 32);
    A.l = A.l * alpha + rsum;
#pragma unroll
    for (int db = 0; db < DV / 32; ++db) A.o[db] = A.o[db] * alpha;
#pragma unroll
    for (int kbk = 0; kbk < 2; ++kbk)
#pragma unroll
      for (int s2 = 0; s2 < 2; ++s2) {
        u32x4 pk; for (int j = 0; j < 4; ++j) pk[j] = pack2(s[kbk][8 * s2 + 2 * j], s[kbk][8 * s2 + 2 * j + 1]);
        const bf16x8 pf = __builtin_bit_cast(bf16x8, pk);
#pragma unroll
        for (int db = 0; db < DV / 32; ++db) {
          const char* vr = vbc + (db * 32 + lr) * VSTR + (kbk * 32 + 16 * s2 + 4 * lh) * 2;
          const u32x2 lo = *(const u32x2*)vr, hi = *(const u32x2*)(vr + 16);
          u32x4 vv = {lo[0], lo[1], hi[0], hi[1]};
          A.o[db] = mfma32(__builtin_bit_cast(bf16x8, vv), pf, A.o[db]);
        }
      }
    }
    if (more) lwrite(cur ^ 1);
#pragma unroll
    for (int i = 0; i < NKC; ++i) rk[i] = rk2[i];
#pragma unroll
    for (int i = 0; i < NVC; ++i) rv[i] = rv2[i];
    __syncthreads();
  }
}

struct MaskNsa { int tq, kmul, kadd, wlim; unsigned long long bits; int tqmin, tqmax;
  DI bool tile(int kt) const { return (bits >> kt) & 1ull; }
  DI bool interior(int kt) const { return ((kt * 64 + 63) * kmul + kadd <= tqmin) && (tqmax - kt * 64 < wlim); }
  DI bool dead(int kt) const { return ((kt * 64) * kmul + kadd > tqmax) || (tqmin - (kt * 64 + 63) >= wlim); }
  DI int hi(int kt) const { const int q = tq - kadd; return (q >= 0 ? q / kmul : -1) - kt * 64; }
  DI int lo(int kt) const { return tq - wlim - kt * 64; }
  DI bool ok(int key) const { return (key * kmul + kadd <= tq) && (tq - key < wlim); } };
struct MaskCausal { int tq, tqmin; DI bool tile(int) const { return true; } DI bool interior(int kt) const { return kt * 64 + 63 <= tqmin; } DI bool dead(int kt) const { return kt * 64 > tqmin + 31; }
  DI int hi(int kt) const { return tq - kt * 64; } DI int lo(int) const { return -(1 << 30); } DI bool ok(int key) const { return key <= tq; } };
#ifdef HOST_EMU
DI char* launder(char* p) { return p; }
#else
DI char* launder(char* p) { asm volatile("" : "+s"(p)); return p; }
#endif
DI void nsa_tile(const Params& pin, int b, int g, int t0, char* lds) {
  Params p = pin; p.ws = launder(p.ws);
  const int t = tid(), w = t >> 6, l = t & 63, lr = l & 31, lh = l >> 5;
  const int qh = w >> 2, hidx = g * 4 + (w & 3), tq = t0 + qh * 32 + lr; const long tok = (long)b * SEQ + tq;
  const float SCL = 0.125f * 1.4426950408889634f;
  bf16x8 qf[4]; load_q<64>(qf, WSP(const bf16_t, Qn) + tok * 1024 + hidx * 64, lh);
  const float* gn = WSP(const float, gn) + tok * 48 + hidx * 3;
  const float g_cmp = gn[0], g_sel = gn[1], g_win = gn[2];
  const long bg = (long)b * NG + g;
  float* imp4 = (float*)lds; float* ofl = (float*)(lds + 65536) + w * 2048 + l; unsigned long long* masks = (unsigned long long*)(lds + LDS_MAIN - 512);
  const int cmp_kt1 = ((t0 + 32) / 16 + 1 + 63) / 64;
  const int diag_kt1 = (t0 + 63) / 64 + 1;
  unsigned long long mymask = ~0ull;
#pragma nounroll
  for (int br = 0; br < 4; ++br) {
    const bf16_t *Kp, *Vp; long ldv; int kt0 = 0, kt1, kmul = 1, kadd = 0, wlim = 1 << 30; unsigned long long bits = ~0ull; float gate;
    if (br <= 1) { Kp = WSP(const bf16_t, Kc) + bg * NCP * 64; Vp = br == 0 ? WSP(const bf16_t, ovlT) : WSP(const bf16_t, VcT) + bg * 64 * NCP; ldv = NCP; kt1 = cmp_kt1; kmul = 16; kadd = 31; gate = g_cmp; }
    else if (br == 2) { Kp = WSP(const bf16_t, Ks) + bg * SEQ * 64; Vp = WSP(const bf16_t, VsT) + bg * 64 * SEQ; ldv = SEQ; kt1 = diag_kt1; bits = mymask; gate = g_sel; }
    else { Kp = WSP(const bf16_t, Kw) + bg * SEQ * 64; Vp = WSP(const bf16_t, VwT) + bg * 64 * SEQ; ldv = SEQ; const int lo = t0 - (WINDOW - 1); kt0 = lo > 0 ? lo / 64 : 0; kt1 = diag_kt1; wlim = WINDOW; gate = g_win; }
    FlashAcc<64> A; flash_init(A);
    flash_run<64, 64>(qf, Kp, 64, Vp, (const bf16_t*)nullptr, ldv, kt0, kt1, SCL, MaskNsa{tq, kmul, kadd, wlim, bits, t0 + qh * 32, t0 + qh * 32 + 31}, A, lds);
    const float inv = A.l > 0.f ? 1.0f / A.l : 0.f;
    if (br == 0) {
#pragma unroll
      for (int db = 0; db < 2; ++db)
#pragma unroll
        for (int i = 0; i < 16; ++i) imp4[(w * 32 + lr) * 64 + db * 32 + crow(i, lh)] = A.o[db][i] * inv;
      __syncthreads();
#pragma nounroll
      for (int qi = 0; qi < 8; ++qi) {
        const int q = w * 8 + qi, tt = t0 + q, tb = tt >> 6;
        const float* ib = imp4 + ((q >> 5) * 4 * 32 + (q & 31)) * 64 + l;
        float v = ib[0] + ib[32 * 64] + ib[2 * 32 * 64] + ib[3 * 32 * 64];
        const bool valid = (l * 64 <= tt) && (l < NSEL);
        const bool forced = (l == 0) || (l == tb) || (l == tb - 1);
        v = valid ? (v + (forced ? 1e4f : 0.f)) : -1e30f;
        const int ki = (int)((f2u(v) & ~63u) | (unsigned)(63 - l));
        int rank = 0;
#pragma unroll
        for (int j = 0; j < 64; ++j) { const int kj = bcast_i(ki, j); rank += (kj > ki) ? 1 : 0; }
        const unsigned long long mk = __ballot(rank < 16);
        if (l == 0) masks[q] = mk;
      }
      __syncthreads();
      mymask = masks[qh * 32 + lr];
      __syncthreads();
    } else {
      const float sc = inv * gate;
      if (br == 1) {
#pragma unroll
        for (int db = 0; db < 2; ++db)
#pragma unroll
          for (int i = 0; i < 16; ++i) ofl[(db * 16 + i) * 64] = A.o[db][i] * sc;
      } else if (br == 2) {
#pragma unroll
        for (int db = 0; db < 2; ++db)
#pragma unroll
          for (int i = 0; i < 16; ++i) ofl[(db * 16 + i) * 64] += A.o[db][i] * sc;
      } else {
        bf16_t* on = WSP(bf16_t, on) + tok * 1024 + hidx * 64;
#pragma unroll
        for (int db = 0; db < 2; ++db)
#pragma unroll
          for (int q4 = 0; q4 < 4; ++q4) { float v[4];
#pragma unroll
            for (int e = 0; e < 4; ++e) v[e] = ofl[(db * 16 + 4 * q4 + e) * 64] + A.o[db][4 * q4 + e] * sc;
            u32x2 pk = {pack2(v[0], v[1]), pack2(v[2], v[3])}; *(u32x2*)(on + db * 32 + 8 * q4 + 4 * lh) = pk; }
      }
    }
  }
}

DI void mla_tile(const Params& pin, int b, int hd, int t0, char* lds) {
  Params p = pin; p.ws = launder(p.ws);
  const int t = tid(), w = t >> 6, l = t & 63, lr = l & 31, lh = l >> 5;
  const int tq = t0 + w * 32 + lr; const long tok = (long)b * SEQ + tq;
  const float SCL = 0.10206207261596575f * 1.4426950408889634f;
  bf16x8 qf[6]; load_q<96>(qf, WSP(const bf16_t, Qm) + tok * (NH * MQK) + hd * MQK, lh);
  FlashAcc<64> A; flash_init(A);
  const long bh = (long)b * NH + hd;
  flash_run<96, 64>(qf, WSP(const bf16_t, Km) + bh * SEQ * MQK, MQK, WSP(const bf16_t, VmT) + bh * 64 * SEQ, (const bf16_t*)nullptr, SEQ, 0, (t0 + 255) / 64 + 1, SCL, MaskCausal{tq, t0 + w * 32}, A, lds);
  const float inv = A.l > 0.f ? 1.0f / A.l : 0.f;
  bf16_t* om = WSP(bf16_t, om) + tok * 1024 + hd * 64;
#pragma unroll
  for (int db = 0; db < 2; ++db)
#pragma unroll
    for (int q4 = 0; q4 < 4; ++q4) { u32x2 v = {pack2(A.o[db][4 * q4] * inv, A.o[db][4 * q4 + 1] * inv), pack2(A.o[db][4 * q4 + 2] * inv, A.o[db][4 * q4 + 3] * inv)}; *(u32x2*)(om + db * 32 + 8 * q4 + 4 * lh) = v; }
}

DI int proj_colmap(int j) {
  if (j < 2560) return j;
  if (j < PC_CKV) return 2608 + (j - PC_CQ);
  if (j < PC_GM) return 3120 + (j - PC_CKV);
  if (j < PC_KR) return 3408 + (j - PC_GM);
  if (j < PC_GN) return 3376 + (j - PC_KR);
  if (j < PC_GN + 48) return 2560 + (j - PC_GN);
  return -1;
}
constexpr int CVN = 4096 / NTHREADS;
DI void convT_load(const float* src, int N, const float* scale, bool projmap, int kt, int nt, float (&v)[CVN]) {
  const int t = tid();
#pragma unroll
  for (int i = 0; i < CVN; ++i) { const int idx = i * NTHREADS + t, kr = idx >> 6, nc = idx & 63; const int n = nt * 64 + nc; const int col = projmap ? proj_colmap(n) : (n < N ? n : -1);
    float x = 0.f; if (col >= 0) { x = __builtin_nontemporal_load(src + (long)(kt * 64 + kr) * N + col); if (scale) x *= scale[kt * 64 + kr]; }
    v[i] = x; }
}
DI void convT_store(int K, bf16_t* dst, int kt, int nt, const float (&v)[CVN], char* lds) {
  float* tile = (float*)lds; const int t = tid();
  __syncthreads();
#pragma unroll
  for (int i = 0; i < CVN; ++i) { const int idx = i * NTHREADS + t, kr = idx >> 6, nc = idx & 63; tile[kr * 65 + nc] = v[i]; }
  __syncthreads();
#pragma unroll
  for (int i = 0; i < 2048 / NTHREADS; ++i) { const int idx = i * NTHREADS + t, n = idx >> 5, kp = idx & 31;
    *(unsigned*)(dst + (long)(nt * 64 + n) * K + kt * 64 + 2 * kp) = pack2(tile[(2 * kp) * 65 + n], tile[(2 * kp + 1) * 65 + n]); }
}
constexpr int CWN = 1024 / NTHREADS;
DI void convW_load(const float* src, int N, bool projmap, int kt, int nt4, f32x4 (&v)[4][CWN]) {
  const int t = tid();
#pragma unroll
  for (int j = 0; j < 4; ++j)
#pragma unroll
    for (int i = 0; i < CWN; ++i) { const int idx = i * NTHREADS + t, kr = idx >> 4, n4 = (idx & 15) * 4; const int n = (nt4 * 4 + j) * 64 + n4;
      f32x4 x = {0.f, 0.f, 0.f, 0.f};
      const int c0 = projmap ? proj_colmap(n) : (n < N ? n : -1), c3 = projmap ? proj_colmap(n + 3) : (n + 3 < N ? n + 3 : -1);
      const float* rowp = src + (long)(kt * 64 + kr) * N;
      if (c0 >= 0 && c3 == c0 + 3 && ((c0 & 3) == 0) && ((N & 3) == 0)) x = __builtin_nontemporal_load((const f32x4*)(rowp + c0));
      else { for (int e = 0; e < 4; ++e) { const int c = projmap ? proj_colmap(n + e) : (n + e < N ? n + e : -1); if (c >= 0) x[e] = rowp[c]; } }
      v[j][i] = x; }
}
DI void convW_store(int K, bf16_t* dst, int kt, int nt4, const f32x4 (&v)[4][CWN], char* lds) {
  float* tile = (float*)lds; const int t = tid();
  __syncthreads();
#pragma unroll
  for (int j = 0; j < 4; ++j)
#pragma unroll
    for (int i = 0; i < CWN; ++i) { const int idx = i * NTHREADS + t, kr = idx >> 4, n4 = (idx & 15) * 4;
#pragma unroll
      for (int e = 0; e < 4; ++e) tile[j * 4160 + kr * 65 + n4 + e] = v[j][i][e]; }
  __syncthreads();
#pragma unroll
  for (int j = 0; j < 4; ++j)
#pragma unroll
    for (int i = 0; i < 2048 / NTHREADS; ++i) { const int idx = i * NTHREADS + t, n = idx >> 5, kp = idx & 31;
      *(unsigned*)(dst + (long)((nt4 * 4 + j) * 64 + n) * K + kt * 64 + 2 * kp) = pack2(tile[j * 4160 + (2 * kp) * 65 + n], tile[j * 4160 + (2 * kp + 1) * 65 + n]); }
}
constexpr int TAB_TPR = D_MODEL / 8, TAB_RPP = NTHREADS / TAB_TPR, TAB_WPR = TAB_TPR >= 64 ? TAB_TPR / 64 : 1;
constexpr int TAB_N = NEXP / (4 * TAB_RPP);
DI void tab_items(const Params& p, char* lds, int first, int stride, int end) {
  const int t = tid(); float* red = (float*)lds;
  f32x4 a[4], bq[4], na[4], nb[4];
  auto tload = [&](int it_, f32x4 (&x)[4], f32x4 (&y)[4]) __attribute__((always_inline)) { const int ic = it_ < end ? it_ : first; const float* src = ic < TAB_N ? p.peer_u : p.peer_v; const int il = ic < TAB_N ? ic : ic - TAB_N;
#pragma unroll
    for (int u = 0; u < 4; ++u) { const long base = ((long)il * 4 + u) * (TAB_RPP * D_MODEL) + t * 8; x[u] = __builtin_nontemporal_load((const f32x4*)(src + base)); y[u] = __builtin_nontemporal_load((const f32x4*)(src + base + 4)); } };
  if (first < end) tload(first, a, bq);
  for (int item = first; item < end; item += stride) { tload(item + stride, na, nb);
    const bool isu = item < TAB_N; const int il = isu ? item : item - TAB_N;
    unsigned char* dst = isu ? WSP(unsigned char, U16) : WSP(unsigned char, V16); float* inv = isu ? WSP(float, uinv) : WSP(float, vinv);
    float mx[4];
#pragma unroll
    for (int u = 0; u < 4; ++u) { float m = 0.f;
#pragma unroll
      for (int e = 0; e < 4; ++e) m = fmaxf(m, fmaxf(fabsf(a[u][e]), fabsf(bq[u][e])));
      for (int sft = 32; sft >= 1; sft >>= 1) m = fmaxf(m, __shfl_xor(m, sft));
      mx[u] = m; }
    if (TAB_WPR > 1) { __syncthreads(); if ((t & 63) == 0) { for (int u = 0; u < 4; ++u) red[(t >> 6) * 4 + u] = mx[u]; } __syncthreads();
#pragma unroll
      for (int u = 0; u < 4; ++u) { float m = 0.f; const int w0 = (t / TAB_TPR) * TAB_WPR; for (int ww = 0; ww < TAB_WPR; ++ww) m = fmaxf(m, red[(w0 + ww) * 4 + u]); mx[u] = m; } }
#pragma unroll
    for (int u = 0; u < 4; ++u) { const long e = ((long)il * 4 + u) * TAB_RPP + t / TAB_TPR; const int col = (t % TAB_TPR) * 8; const float m = mx[u] > 0.f ? mx[u] : 1.f; const float sc = 440.0f / m;
      u32x2 o = {enc_fp8x4(a[u][0] * sc, a[u][1] * sc, a[u][2] * sc, a[u][3] * sc), enc_fp8x4(bq[u][0] * sc, bq[u][1] * sc, bq[u][2] * sc, bq[u][3] * sc)};
      *(u32x2*)(dst + ((long)(col >> 7) * NEXP + e) * 128 + (col & 127)) = o;
      if ((t % TAB_TPR) == 0) inv[e] = m * (1.0f / 440.0f); }
#pragma unroll
    for (int u = 0; u < 4; ++u) { a[u] = na[u]; bq[u] = nb[u]; } }
}
constexpr int LC_N0 = (1024 / 64) * (D_MODEL / 256), LC_N2 = (D_MODEL / 64) * (D_MODEL / 256), LC_N3 = (D_MODEL / 64) * (2048 / 256), LC_TOTAL = 2 * LC_N0 + LC_N2 + LC_N3;
DI void late_conv_items(const Params& p, char* lds, int first, int stride, int end) {
  auto job = [&](int it, const float*& src, int& K, int& N, bf16_t*& dst, int& kt, int& nt4) __attribute__((always_inline)) {
    int r = it;
    if (r < LC_N0) { src = p.w_branch_nsa; K = 1024; N = D_MODEL; dst = WSP(bf16_t, WnT); }
    else if ((r -= LC_N0) < LC_N0) { src = p.w_branch_mla; K = 1024; N = D_MODEL; dst = WSP(bf16_t, WmT); }
    else if ((r -= LC_N0) < LC_N2) { src = p.w_out; K = D_MODEL; N = D_MODEL; dst = WSP(bf16_t, WoT); }
    else { r -= LC_N2; src = p.peer_w_q; K = D_MODEL; N = 2048; dst = WSP(bf16_t, WpqT); }
    const int nkt = K / 64; kt = r % nkt; nt4 = r / nkt; };
  f32x4 cv[4][CWN], nv[4][CWN]; const float* src; int K, N, kt, nt4; bf16_t* dst;
  if (first < end) { job(first, src, K, N, dst, kt, nt4); convW_load(src, N, false, kt, nt4, cv); }
  for (int item = first; item < end; item += stride) { const int nx = item + stride < end ? item + stride : item;
    const float* s2; int K2, N2, kt2, nt2; bf16_t* d2; job(nx, s2, K2, N2, d2, kt2, nt2); convW_load(s2, N2, false, kt2, nt2, nv);
    job(item, src, K, N, dst, kt, nt4); convW_store(K, dst, kt, nt4, cv, lds);
#pragma unroll
    for (int j = 0; j < 4; ++j)
#pragma unroll
      for (int i = 0; i < CWN; ++i) cv[j][i] = nv[j][i]; }
}

DI void phase0(const Params& p, char* lds) {
  const int t = tid();
  int item = blockIdx.x;
  constexpr int N_ADA = 6 * D_MODEL / 64;
  for (; item < N_ADA; item += gridDim.x) {
    float* sc = (float*)lds;
    __syncthreads();
    for (int i = t; i < BATCH * D_MODEL; i += NTHREADS) { const float v = p.c[i]; sc[i] = v * fsigmoid(v); }
    __syncthreads();
    const int w = t >> 6, l = t & 63, cqd = l & 15, rs = l >> 4; const int n0 = item * 64 + cqd * 4;
    f32x4 acc[BATCH]; for (int b = 0; b < BATCH; ++b) acc[b] = (f32x4){0.f, 0.f, 0.f, 0.f};
    for (int j0 = 0; j0 < D_MODEL / (4 * NW); j0 += 8) { f32x4 wv[8];
#pragma unroll
      for (int u = 0; u < 8; ++u) { const int k = (j0 + u) * (4 * NW) + w * 4 + rs; wv[u] = __builtin_nontemporal_load((const f32x4*)(p.ada_w + (long)k * (6 * D_MODEL) + n0)); }
#pragma unroll
      for (int u = 0; u < 8; ++u) { const int k = (j0 + u) * (4 * NW) + w * 4 + rs;
#pragma unroll
        for (int b = 0; b < BATCH; ++b) acc[b] += wv[u] * sc[b * D_MODEL + k]; } }
    float* red = (float*)(lds + BATCH * D_MODEL * 4);
    for (int b = 0; b < BATCH; ++b) for (int e = 0; e < 4; ++e) { float v = acc[b][e]; v += __shfl_xor(v, 16); v += __shfl_xor(v, 32); if (rs == 0) red[(w * BATCH + b) * 64 + cqd * 4 + e] = v; }
    __syncthreads();
    if (t < 64 * BATCH) { const int b = t >> 6, cc = t & 63; float v = 0.f; for (int ww = 0; ww < NW; ++ww) v += red[(ww * BATCH + b) * 64 + cc];
      WSP(float, mod)[(long)b * 6 * D_MODEL + item * 64 + cc] = v + p.ada_b[item * 64 + cc]; }
  }
  item -= N_ADA;
  auto convjob = [&](const float* src, int K, int N, int Npad, bf16_t* dst, const float* scale, bool projmap) __attribute__((always_inline)) {
    const int nkt = K / 64, nnt = Npad / 64, n = nkt * nnt;
    float cv[CVN], nv[CVN];
    if (item < n) convT_load(src, N, scale, projmap, item % nkt, item / nkt, cv);
    for (; item < n; item += gridDim.x) { const int nx = item + (int)gridDim.x < n ? item + (int)gridDim.x : item;
      convT_load(src, N, scale, projmap, nx % nkt, nx / nkt, nv);
      convT_store(K, dst, item % nkt, item / nkt, cv, lds);
#pragma unroll
      for (int i = 0; i < CVN; ++i) cv[i] = nv[i]; }
    item -= n; };
  { const int nkt = D_MODEL / 64, n = nkt * (NPROJ / 256); f32x4 cv[4][CWN], nv[4][CWN];
    if (item < n) convW_load(p.w_in, IN_COLS, true, item % nkt, item / nkt, cv);
    for (; item < n; item += gridDim.x) { const int nx = item + (int)gridDim.x < n ? item + (int)gridDim.x : item;
      convW_load(p.w_in, IN_COLS, true, nx % nkt, nx / nkt, nv);
      convW_store(D_MODEL, WSP(bf16_t, WinT), item % nkt, item / nkt, cv, lds);
#pragma unroll
      for (int j = 0; j < 4; ++j)
#pragma unroll
        for (int i = 0; i < CWN; ++i) cv[j][i] = nv[j][i]; }
    item -= n; }
  convjob(p.cmp_w1, 2048, CMP_HIDDEN, CMP_HIDDEN, WSP(bf16_t, W1T), nullptr, false);
  convjob(p.cmp_w1 + (size_t)2048 * CMP_HIDDEN, 2048, CMP_HIDDEN, CMP_HIDDEN, WSP(bf16_t, W1T) + (size_t)CMP_HIDDEN * 2048, nullptr, false);
  convjob(p.cmp_w2, CMP_HIDDEN, 64, 128, WSP(bf16_t, W2T), nullptr, false);
  convjob(p.cmp_w2 + CMP_HIDDEN * 64, CMP_HIDDEN, 64, 128, WSP(bf16_t, W2T) + 128 * CMP_HIDDEN, nullptr, false);
  convjob(p.mla_w_q_up, QR, NH * MQK, NH * MQK, WSP(bf16_t, WquT), p.mla_q_norm_g, false);
  convjob(p.mla_w_kv_up, KVR, NH * 128, NH * 128, WSP(bf16_t, WkvT), p.mla_kv_norm_g, false);
  auto cvtjob = [&](const float* src, bf16_t* dst, long cnt) __attribute__((always_inline)) {
    const int n = (int)(cnt / (NTHREADS * 8));
    for (; item < n; item += gridDim.x) { const long base = (long)item * (NTHREADS * 8) + t * 8; const f32x4 a = *(const f32x4*)(src + base), bq = *(const f32x4*)(src + base + 4);
      u32x4 o = {pack2(a[0], a[1]), pack2(a[2], a[3]), pack2(bq[0], bq[1]), pack2(bq[2], bq[3])}; *(u32x4*)(dst + base) = o; }
    item -= n; };
  cvtjob(p.peer_sub_keys, WSP(bf16_t, SK), 16 * 128 * 128);
  { const int n = (NTOK + NTHREADS - 1) / NTHREADS;
    for (; item < n; item += gridDim.x) { const int tok = item * NTHREADS + t; if (tok < NTOK) { const float pf = (float)p.pos[tok];
        float* rn = WSP(float, ropeN) + (long)tok * 16; float* rm = WSP(float, ropeM) + (long)tok * 32;
        for (int i = 0; i < 8; ++i) { const float inv = fexp2(-(float)i * (2.0f / 16.0f) * 18.931568569324174f); const float ang = pf * inv; double r = (double)ang * 0.15915494309189535; r -= __builtin_rint(r); rn[i] = fcos_rev((float)r); rn[8 + i] = fsin_rev((float)r); }
        for (int i = 0; i < 16; ++i) { const float inv = fexp2(-(float)i * (2.0f / 32.0f) * 18.931568569324174f); const float ang = pf * inv; double r = (double)ang * 0.15915494309189535; r -= __builtin_rint(r); rm[i] = fcos_rev((float)r); rm[16 + i] = fsin_rev((float)r); } } }
    item -= n; }
  { const int n = 8;
    for (; item < n; item += gridDim.x) { const int which = item >> 2, j0 = (item & 3) * 64; const int w = t >> 6, l = t & 63;
      const float* pe = p.cmp_pe + which * 2048; const float* w1 = p.cmp_w1 + (size_t)which * 2048 * CMP_HIDDEN;
      float s = 0.f; for (int k = w; k < 2048; k += NW) s += pe[k] * w1[(long)k * CMP_HIDDEN + j0 + l];
      float* red = (float*)lds; __syncthreads(); red[w * 64 + l] = s; __syncthreads();
      if (t < 64) { float v = p.cmp_b1[which * CMP_HIDDEN + j0 + t]; for (int ww = 0; ww < NW; ++ww) v += red[ww * 64 + t]; WSP(float, cmpbias)[which * CMP_HIDDEN + j0 + t] = v; } }
    item -= n; }
  { const int n = 1;
    for (; item < n; item += gridDim.x) { bf16_t* o = WSP(bf16_t, ovlT); for (int i = t; i < 64 * NCP + 2048; i += NTHREADS) { const int s = i / NCP, nn = i % NCP; o[i] = (s < 64 && nn >= 4 * s - 1 && nn <= 4 * s + 3) ? (bf16_t)0x3f80 : (bf16_t)0; } }
    item -= n; }
}

constexpr int RV = D_MODEL / 256;
DI void phase_prenorm(const Params& p) {
  const int t_ = tid(); const int w = t_ >> 6, l = t_ & 63; const float* mod = WSP(const float, mod); bf16_t* h = WSP(bf16_t, h);
  for (long row = (long)blockIdx.x * NW + w; row < NTOK; row += (long)gridDim.x * NW) { const int b = (int)(row / SEQ);
    f32x4 xv[RV]; float ss = 0.f;
    for (int i = 0; i < RV; ++i) { xv[i] = *(const f32x4*)(p.x + row * D_MODEL + (i * 64 + l) * 4); ss += xv[i][0] * xv[i][0] + xv[i][1] * xv[i][1] + xv[i][2] * xv[i][2] + xv[i][3] * xv[i][3]; }
    const float rs = frsq(wave_sum(ss) / (float)D_MODEL + NORM_EPS);
    for (int i = 0; i < RV; ++i) { const int c0 = (i * 64 + l) * 4; const f32x4 g = *(const f32x4*)(p.attn_pre_g + c0), sh = *(const f32x4*)(mod + (long)b * 6 * D_MODEL + c0), sc = *(const f32x4*)(mod + (long)b * 6 * D_MODEL + D_MODEL + c0);
      f32x4 v = xv[i] * rs * g * (sc + 1.0f) + sh; u32x2 o = {pack2(v[0], v[1]), pack2(v[2], v[3])}; *(u32x2*)(h + row * D_MODEL + c0) = o; } }
}
DI void phase_postattn(const Params& p) {
  const int t_ = tid(); const int w = t_ >> 6, l = t_ & 63; const float* mod = WSP(const float, mod); bf16_t* h2 = WSP(bf16_t, h2); const bf16_t* y = WSP(const bf16_t, y);
  for (long row = (long)blockIdx.x * NW + w; row < NTOK; row += (long)gridDim.x * NW) { const int b = (int)(row / SEQ); const float* mb = mod + (long)b * 6 * D_MODEL;
    f32x4 xv[RV], yq[RV]; float ss = 0.f, sy = 0.f;
#pragma unroll
    for (int i = 0; i < RV; ++i) { const int c0 = (i * 64 + l) * 4; const u32x2 yy = *(const u32x2*)(y + row * D_MODEL + c0); yq[i] = (f32x4){bflo(yy[0]), bfhi(yy[0]), bflo(yy[1]), bfhi(yy[1])};
      sy += yq[i][0] * yq[i][0] + yq[i][1] * yq[i][1] + yq[i][2] * yq[i][2] + yq[i][3] * yq[i][3]; }
    const float rsy = frsq(wave_sum(sy) / (float)D_MODEL + NORM_EPS);
#pragma unroll
    for (int i = 0; i < RV; ++i) { const int c0 = (i * 64 + l) * 4; const f32x4 yv = yq[i];
      const f32x4 g = *(const f32x4*)(p.attn_post_g + c0), ga = *(const f32x4*)(mb + 2 * D_MODEL + c0);
      xv[i] = *(const f32x4*)(p.x + row * D_MODEL + c0) + ga * (yv * rsy * g);
      *(f32x4*)(p.out + row * D_MODEL + c0) = xv[i];
      ss += xv[i][0] * xv[i][0] + xv[i][1] * xv[i][1] + xv[i][2] * xv[i][2] + xv[i][3] * xv[i][3]; }
    const float rs = frsq(wave_sum(ss) / (float)D_MODEL + NORM_EPS);
    for (int i = 0; i < RV; ++i) { const int c0 = (i * 64 + l) * 4; const f32x4 g = *(const f32x4*)(p.ffn_pre_g + c0), sh = *(const f32x4*)(mb + 3 * D_MODEL + c0), sc = *(const f32x4*)(mb + 4 * D_MODEL + c0);
      f32x4 v = xv[i] * rs * g * (sc + 1.0f) + sh; u32x2 o = {pack2(v[0], v[1]), pack2(v[2], v[3])}; *(u32x2*)(h2 + row * D_MODEL + c0) = o; } }
}

DI int okey(float v) { int k = (int)f2u(v); return k ^ ((k >> 31) & 0x7fffffff); }
#ifdef HOST_EMU
DI int permute_push(int dst_lane, int v) { return emu_ds_permute(dst_lane, v); }
#else
DI int permute_push(int dst_lane, int v) { return __builtin_amdgcn_ds_permute(dst_lane << 2, v); }
#endif
#ifdef HOST_EMU
DI int lanes_below(unsigned long long m) { return __builtin_popcountll(m & ((1ull << (tid() & 63)) - 1ull)); }
#else
DI int lanes_below(unsigned long long m) { return (int)__builtin_amdgcn_mbcnt_hi((unsigned)(m >> 32), __builtin_amdgcn_mbcnt_lo((unsigned)m, 0u)); }
#endif
DI void phase_peer_topk(const Params& p) {
  const int t_ = tid(); const int w = t_ >> 6, l = t_ & 63; const float* sc = WSP(const float, sc); unsigned* picks = WSP(unsigned, picks);
  int ci, cj;
  if (l < 16) { ci = 0; cj = l; } else if (l < 24) { ci = 1; cj = l - 16; } else if (l < 29) { ci = 2; cj = l - 24; } else if (l < 33) { ci = 3; cj = l - 29; }
  else if (l < 36) { ci = 4; cj = l - 33; } else if (l < 42) { ci = 5 + ((l - 36) >> 1); cj = (l - 36) & 1; } else { ci = 8 + (l - 42); cj = 0; }
  const bool cvalid = l < 50; if (!cvalid) { ci = 0; cj = 0; }
  for (long it = (long)blockIdx.x * NW + w; it < (long)NTOK * PH; it += (long)gridDim.x * NW) { const long tok = it / PH; const int hh = (int)(it % PH);
    float sv[2]; int si[2];
    float a0[2], a1[2]; int k0[2], k1[2]; unsigned u0[2], u1[2], T[2];
#pragma unroll
    for (int pp = 0; pp < 2; ++pp) { const float* s = sc + tok * 2048 + (hh * 2 + pp) * 128; a0[pp] = s[l]; a1[pp] = s[l + 64];
      k0[pp] = (okey(a0[pp]) & ~127) | (127 - l); k1[pp] = (okey(a1[pp]) & ~127) | (63 - l);
      u0[pp] = (unsigned)k0[pp] ^ 0x80000000u; u1[pp] = (unsigned)k1[pp] ^ 0x80000000u; T[pp] = 0u; }
#pragma unroll
    for (int bit = 31; bit >= 0; --bit) {
#pragma unroll
      for (int pp = 0; pp < 2; ++pp) { const unsigned cand = T[pp] | (1u << bit);
        const int cnt = __builtin_popcountll(__ballot(u0[pp] >= cand)) + __builtin_popcountll(__ballot(u1[pp] >= cand)); if (cnt >= 16) T[pp] = cand; } }
    int kq[2], vq[2], iq[2];
#pragma unroll
    for (int pp = 0; pp < 2; ++pp) {
      const bool s0 = u0[pp] >= T[pp], s1 = u1[pp] >= T[pp]; const unsigned long long m0 = __ballot(s0), m1 = __ballot(s1);
      const int c0 = s0 ? lanes_below(m0) : 63, c1 = s1 ? __builtin_popcountll(m0) + lanes_below(m1) : 63;
      kq[pp] = permute_push(c0, k0[pp]) | permute_push(c1, k1[pp]);
      vq[pp] = permute_push(c0, (int)f2u(a0[pp])) | permute_push(c1, (int)f2u(a1[pp]));
      iq[pp] = permute_push(c0, l) | permute_push(c1, l + 64); }
    int rk[2] = {0, 0};
#pragma unroll
    for (int j = 0; j < 16; ++j) { const int q0 = bcast_i(kq[0], j), q1 = bcast_i(kq[1], j); rk[0] += (q0 > kq[0]); rk[1] += (q1 > kq[1]); }
#pragma unroll
    for (int pp = 0; pp < 2; ++pp) { const int dq = l < 16 ? rk[pp] : 63; sv[pp] = u2f((unsigned)permute_push(dq, vq[pp])); si[pp] = permute_push(dq, iq[pp]); }
    const float cand = shfl_f(sv[0], ci) + shfl_f(sv[1], cj); const int flat = ci * 16 + cj;
    const int kc = cvalid ? ((okey(cand) & ~255) | (255 - flat)) : (int)0x80000000;
    int rc = 0;
#pragma unroll
    for (int j = 0; j < 64; ++j) { const int q = bcast_i(kc, j); rc += (q > kc); }
    const int dc = (cvalid && rc < 16) ? rc : 63;
    const float tv = u2f((unsigned)permute_push(dc, (int)f2u(cand))); const int tp = permute_push(dc, flat);
    const int e1 = shfl_i(si[0], (tp >> 4) & 15), e2 = shfl_i(si[1], tp & 15);
    const float mx = bcast_f(tv, 0); float e = (l < 16) ? fexp2((tv - mx) * 1.4426950408889634f) : 0.f;
    float sum = e; for (int m = 8; m >= 1; m >>= 1) sum += __shfl_xor(sum, m);
    if (l < 16) { unsigned* dst = picks + (tok * NPICK + hh * 16 + l) * 2; dst[0] = (unsigned)(e1 * PNK + e2); dst[1] = f2u(e / sum); } }
}

#ifdef HOST_EMU
#define PIN_ORDER(acc, nxt) do {} while (0)
#else
#define PIN_ORDER(acc, nxt) asm volatile("" : "+v"(acc), "+v"((nxt)[0]), "+v"((nxt)[1]), "+v"((nxt)[2]), "+v"((nxt)[3]))
#endif
#ifdef HOST_EMU
DI float xch1(float x) { return __shfl_xor(x, 1); }
DI float xch2(float x) { return __shfl_xor(x, 2); }
DI float xch7(float x) { return __shfl(x, (tid() & 63) ^ 7); }
DI float xch8(float x) { return __shfl_xor(x, 8); }
DI float xch16(float x) { return __shfl_xor(x, 16); }
DI float xch32(float x) { return __shfl_xor(x, 32); }
#else
DI float xch1(float x) { return u2f((unsigned)__builtin_amdgcn_update_dpp(0, (int)f2u(x), 0xB1, 0xF, 0xF, true)); }
DI float xch2(float x) { return u2f((unsigned)__builtin_amdgcn_update_dpp(0, (int)f2u(x), 0x4E, 0xF, 0xF, true)); }
DI float xch7(float x) { return u2f((unsigned)__builtin_amdgcn_update_dpp(0, (int)f2u(x), 0x141, 0xF, 0xF, true)); }
DI float xch8(float x) { return u2f((unsigned)__builtin_amdgcn_update_dpp(0, (int)f2u(x), 0x128, 0xF, 0xF, true)); }
DI float xch16(float x) { const u32x2 r = __builtin_amdgcn_permlane16_swap(f2u(x), f2u(x), false, false); return u2f((tid() & 16) ? r[0] : r[1]); }
DI float xch32(float x) { const u32x2 r = __builtin_amdgcn_permlane32_swap(f2u(x), f2u(x), false, false); return u2f((tid() & 32) ? r[0] : r[1]); }
#endif
constexpr int NSL = D_MODEL / 128;
struct SliceSched { int g, ngroups, bi, nb; };
DI SliceSched slice_sched() { SliceSched s; const int G = gridDim.x; s.ngroups = G < 8 ? G : 8; s.g = blockIdx.x % s.ngroups; s.bi = blockIdx.x / s.ngroups; s.nb = (G - s.g + s.ngroups - 1) / s.ngroups; return s; }

DI void phase_peer_u(const Params& p) {
  const int t_ = tid(); const int w = t_ >> 6, l = t_ & 63, c8 = l & 7, pg = l >> 3; const SliceSched ss = slice_sched();
  const bf16_t* h2 = WSP(const bf16_t, h2); const unsigned* picks = WSP(const unsigned, picks); bf16_t* apart = WSP(bf16_t, apart);
  const long tstep = (long)ss.nb * NW;
  for (int s = ss.g; s < NSL; s += ss.ngroups) {
    const unsigned char* U = WSP(const unsigned char, U16) + (long)s * NEXP * 128 + c8 * 16;
    auto ldmeta = [&](long tok, u32x2& pk, u32x4& hq0, u32x4& hq1) __attribute__((always_inline)) { const long tc = tok < NTOK ? tok : NTOK - 1;
      { const unsigned* pp = picks + ((unsigned)tc * (unsigned)NPICK + 2u * (unsigned)l) * 2u; pk[0] = pp[0]; pk[1] = pp[2]; } const bf16_t* hp = h2 + ((unsigned)tc * (unsigned)D_MODEL + (unsigned)(s * 128 + c8 * 16)); hq0 = *(const u32x4*)hp; hq1 = *(const u32x4*)(hp + 8); };
    auto issue = [&](const u32x2& pk, u32x4 (&uv)[16]) __attribute__((always_inline)) { const int ipair = (int)((pk[0] & 0xffffu) | (pk[1] << 16));
#pragma unroll
      for (int r2 = 0; r2 < 8; ++r2) { const unsigned pr = (unsigned)shfl_i(ipair, pg * 8 + r2);
        uv[2 * r2] = *(const u32x4*)(U + ((pr & 0xffffu) << 7)); uv[2 * r2 + 1] = *(const u32x4*)(U + ((pr >> 16) << 7)); } };
    auto reduce = [&](long tok, u32x4 (&uv)[16], const u32x4& hq0, const u32x4& hq1) __attribute__((always_inline)) {
      f32x2 hv[8];
#pragma unroll
      for (int q = 0; q < 4; ++q) { hv[q] = (f32x2){bflo(hq0[q]), bfhi(hq0[q])}; hv[4 + q] = (f32x2){bflo(hq1[q]), bfhi(hq1[q])}; }
      float d[16];
#pragma unroll
      for (int r = 0; r < 16; ++r) { f32x2 s2 = {0.f, 0.f};
#pragma unroll
        for (int q = 0; q < 4; ++q) { s2 = __builtin_elementwise_fma(dec_fp8_lo(uv[r][q]), hv[2 * q], s2); s2 = __builtin_elementwise_fma(dec_fp8_hi(uv[r][q]), hv[2 * q + 1], s2); }
        float sacc = s2[0] + s2[1];
        if (r + 1 < 16) PIN_ORDER(sacc, uv[r + 1 < 16 ? r + 1 : 15]);
        d[r] = sacc; }
      float d8[8], d4[4], d2[2];
#pragma unroll
      for (int k = 0; k < 8; ++k) { const bool hi = l & 4; const float keep = hi ? d[8 + k] : d[k], send = hi ? d[k] : d[8 + k]; d8[k] = keep + xch7(send); }
#pragma unroll
      for (int k = 0; k < 4; ++k) { const bool hi = l & 2; const float keep = hi ? d8[4 + k] : d8[k], send = hi ? d8[k] : d8[4 + k]; d4[k] = keep + xch2(send); }
#pragma unroll
      for (int k = 0; k < 2; ++k) { const bool hi = l & 1; const float keep = hi ? d4[2 + k] : d4[k], send = hi ? d4[k] : d4[2 + k]; d2[k] = keep + xch1(send); }
      const int r0 = ((l & 4) ? 8 : 0) + ((l & 2) ? 4 : 0) + ((l & 1) ? 2 : 0);
      if (tok < NTOK) *(unsigned*)(apart + (((unsigned)s * (unsigned)NTOK + (unsigned)tok) * (unsigned)NPICK + (unsigned)(pg * 16 + r0))) = pack2(d2[0], d2[1]); };
    long tok = (long)ss.bi * NW + w;
    u32x2 pkA, pkB; u32x4 hA0, hA1, hB0, hB1, uvA[16], uvB[16];
    ldmeta(tok, pkA, hA0, hA1); issue(pkA, uvA); ldmeta(tok + tstep, pkB, hB0, hB1);
    for (; tok < NTOK; tok += 2 * tstep) {
      u32x2 pkC; u32x4 hC0, hC1;
      issue(pkB, uvB); ldmeta(tok + 2 * tstep, pkC, hC0, hC1);
      reduce(tok, uvA, hA0, hA1);
      issue(pkC, uvA); ldmeta(tok + 3 * tstep, pkB, hA0, hA1);
      reduce(tok + tstep, uvB, hB0, hB1);
      const u32x4 t0 = hA0, t1 = hA1; hA0 = hC0; hA1 = hC1; hB0 = t0; hB1 = t1;
    }
  }
}
DI void phase_peer_w(const Params& p) {
  const unsigned* picks = WSP(const unsigned, picks); const bf16_t* apart = WSP(const bf16_t, apart); unsigned* pw = WSP(unsigned, pw);
  const float* uinv = WSP(const float, uinv); const float* vinv = WSP(const float, vinv);
  for (long i = (long)blockIdx.x * NTHREADS + tid(); i < (long)NTOK * NPICK; i += (long)gridDim.x * NTHREADS) {
    float a = 0.f;
#pragma unroll 8
    for (int s = 0; s < NSL; ++s) a += bf2f(apart[(long)s * NTOK * NPICK + i]);
    const unsigned idx = picks[i * 2]; const float gate = u2f(picks[i * 2 + 1]);
    a *= uinv[idx];
    pw[i] = (idx & 0xffffu) | (pack2(0.f, fgelu_tanh(a) * gate * vinv[idx]) & 0xffff0000u);
  }
}
DI void phase_peer_v(const Params& p) {
  const int t_ = tid(); const int w = t_ >> 6, l = t_ & 63, c8 = l & 7, pg = l >> 3; const SliceSched ss = slice_sched();
  const unsigned* pw = WSP(const unsigned, pw); bf16_t* yb = WSP(bf16_t, yb); float* ypart2 = WSP(float, ypart2);
  const long tstep = (long)ss.nb * NW;
  for (int s = ss.g; s < NSL; s += ss.ngroups) {
    const unsigned char* V = WSP(const unsigned char, V16) + (long)s * NEXP * 128 + c8 * 16;
    auto ldmeta = [&](long tok, u32x2& pq) __attribute__((always_inline)) { const unsigned tc = (unsigned)(tok < NTOK ? tok : NTOK - 1); pq = *(const u32x2*)(pw + (tc * (unsigned)NPICK + 2u * (unsigned)l)); };
    auto issue_half = [&](const u32x2& pq, int half, u32x4 (&vv)[8], unsigned (&wg)[4]) __attribute__((always_inline)) { const int p0 = (int)pq[0], p1 = (int)pq[1];
#pragma unroll
      for (int q = 0; q < 4; ++q) { const int r2 = half * 4 + q; const unsigned re = (unsigned)shfl_i(p0, pg * 8 + r2), ro = (unsigned)shfl_i(p1, pg * 8 + r2); wg[q] = (re >> 16) | (ro & 0xffff0000u);
        vv[2 * q] = *(const u32x4*)(V + ((re & 0xffffu) << 7)); vv[2 * q + 1] = *(const u32x4*)(V + ((ro & 0xffffu) << 7)); } };
    auto acc_half = [&](u32x4 (&vv)[8], unsigned (&wg)[4], f32x2 (&acc)[8]) __attribute__((always_inline)) {
#pragma unroll
      for (int r = 0; r < 8; ++r) { const float wr_ = (r & 1) ? bfhi(wg[r >> 1]) : bflo(wg[r >> 1]); const f32x2 w2 = {wr_, wr_};
#pragma unroll
        for (int q = 0; q < 4; ++q) { acc[2 * q] = __builtin_elementwise_fma(dec_fp8_lo(vv[r][q]), w2, acc[2 * q]); acc[2 * q + 1] = __builtin_elementwise_fma(dec_fp8_hi(vv[r][q]), w2, acc[2 * q + 1]); }
        if (r + 1 < 8) PIN_ORDER(acc[0], vv[r + 1 < 8 ? r + 1 : 7]); } };
    auto finish = [&](long tok, f32x2 (&acc2)[8]) __attribute__((always_inline)) { float acc[16];
#pragma unroll
      for (int j = 0; j < 8; ++j) { acc[2 * j] = acc2[j][0]; acc[2 * j + 1] = acc2[j][1]; }
      float a8[8], a4[4], a2[2];
#pragma unroll
      for (int k = 0; k < 8; ++k) { const bool hi = l & 32; const float keep = hi ? acc[8 + k] : acc[k], send = hi ? acc[k] : acc[8 + k]; a8[k] = keep + xch32(send); }
#pragma unroll
      for (int k = 0; k < 4; ++k) { const bool hi = l & 16; const float keep = hi ? a8[4 + k] : a8[k], send = hi ? a8[k] : a8[4 + k]; a4[k] = keep + xch16(send); }
#pragma unroll
      for (int k = 0; k < 2; ++k) { const bool hi = l & 8; const float keep = hi ? a4[2 + k] : a4[k], send = hi ? a4[k] : a4[2 + k]; a2[k] = keep + xch8(send); }
      const int col = c8 * 16 + ((l & 32) ? 8 : 0) + ((l & 16) ? 4 : 0) + ((l & 8) ? 2 : 0);
      const float sq = wave_sum(a2[0] * a2[0] + a2[1] * a2[1]);
      if (tok < NTOK) { *(unsigned*)(yb + ((unsigned)tok * (unsigned)D_MODEL + (unsigned)(s * 128 + col))) = pack2(a2[0], a2[1]); if (l == 0) ypart2[(unsigned)s * (unsigned)NTOK + (unsigned)tok] = sq; } };
    long tok = (long)ss.bi * NW + w;
    u32x2 pqCur, pqNext; u32x4 vvA[8], vvB[8]; unsigned wgA[4], wgB[4];
    ldmeta(tok, pqCur); issue_half(pqCur, 0, vvA, wgA); ldmeta(tok + tstep, pqNext);
    for (; tok < NTOK; tok += tstep) {
      u32x2 pqN2; issue_half(pqCur, 1, vvB, wgB); ldmeta(tok + 2 * tstep, pqN2);
      f32x2 acc[8];
#pragma unroll
      for (int j = 0; j < 8; ++j) acc[j] = (f32x2){0.f, 0.f};
      acc_half(vvA, wgA, acc);
      issue_half(pqNext, 0, vvA, wgA);
      acc_half(vvB, wgB, acc);
      finish(tok, acc);
      pqCur = pqNext; pqNext = pqN2;
    }
  }
}
DI void phase_peer_final(const Params& p) {
  const int t_ = tid(); const int w = t_ >> 6, l = t_ & 63; const float* mod = WSP(const float, mod); const bf16_t* yb = WSP(const bf16_t, yb); const float* ypart2 = WSP(const float, ypart2);
  for (long row = (long)blockIdx.x * NW + w; row < NTOK; row += (long)gridDim.x * NW) { const int b = (int)(row / SEQ); const float* mb = mod + (long)b * 6 * D_MODEL + 5 * D_MODEL;
    const float rs = row_rstd(ypart2, NSL, row, D_MODEL);
#pragma unroll
    for (int i = 0; i < RV; ++i) { const int c0 = (i * 64 + l) * 4; const u32x2 yy = *(const u32x2*)(yb + row * D_MODEL + c0); const f32x4 yv = {bflo(yy[0]), bfhi(yy[0]), bflo(yy[1]), bfhi(yy[1])};
      float* op = p.out + row * D_MODEL + c0; const f32x4 g = *(const f32x4*)(p.ffn_post_g + c0), gf = *(const f32x4*)(mb + c0);
      *(f32x4*)op = *(const f32x4*)op + gf * (yv * rs * g); } }
}

#ifdef HOST_EMU
struct GridBar { int dummy; };
DI GridBar gridbar_init(const Params&, char*) { return GridBar{0}; }
DI void gsync(const GridBar&) { emu_grid_sync(); }
#else
#define XB_TMO      128
#define XB_XCNT(j)  (256  + 64 * (j))
#define XB_XSUB(j)  (1280 + 64 * (j))
#define XB_XGEN(j)  (2304 + 64 * (j))
#define XB_TOP      3328
#define XB_TOPGEN   3392
#define XCD_BAR_WORDS 3456
#define XB_SPIN_CAP (1u << 22)
DI unsigned xb_ld(unsigned* p) { return __hip_atomic_load(p, __ATOMIC_RELAXED, __HIP_MEMORY_SCOPE_AGENT); }
DI unsigned xb_add(unsigned* p, unsigned v) { return __hip_atomic_fetch_add(p, v, __ATOMIC_RELAXED, __HIP_MEMORY_SCOPE_AGENT); }
DI unsigned xb_xcc_id() { return (unsigned)__builtin_amdgcn_s_getreg((3 << 11) | 20) & 0xFu; }
#define XB_SPIN(cond, bar) do { unsigned _sp = 0; while (cond) { __builtin_amdgcn_s_sleep(1); \
    if ((++_sp & 255u) == 0u) { if (xb_ld(&(bar)[XB_TMO])) break; if (_sp > XB_SPIN_CAP) { atomicAdd(&(bar)[XB_TMO], 1u); break; } } } } while (0)
struct GridBar { unsigned* bar; unsigned x; volatile unsigned* st; };
DI GridBar gridbar_init(const Params& p, char* lds) {
  GridBar b; b.bar = (unsigned*)(p.ws + WL.bar); b.x = xb_xcc_id(); b.st = (volatile unsigned*)(lds + LDS_MAIN);
  if (threadIdx.x == 0) { b.st[0] = 0u; b.st[1] = 0u; (void)xb_add(&b.bar[XB_XCNT(b.x)], 1u); }
  __syncthreads();
  return b;
}
DI void xb_complete(unsigned* bar, unsigned x, unsigned& nloc, unsigned& nx) {
  const unsigned G = gridDim.x; unsigned sum, cnt, mine, sp = 0u;
  for (;;) { sum = 0u; cnt = 0u; mine = 0u;
#pragma unroll
    for (unsigned j = 0; j < 16; ++j) { const unsigned c = xb_ld(&bar[XB_XCNT(j)]); sum += c; cnt += (c > 0u) ? 1u : 0u; mine = (j == x) ? c : mine; }
    if (sum == G) break;
    __builtin_amdgcn_s_sleep(1);
    if ((++sp & 255u) == 0u) { if (xb_ld(&bar[XB_TMO])) break; if (sp > XB_SPIN_CAP) { atomicAdd(&bar[XB_TMO], 1u); break; } } }
  nloc = mine > 0u ? mine : 1u; nx = cnt > 0u ? cnt : 1u;
}
DI void gsync(const GridBar& b) {
  asm volatile("s_waitcnt vmcnt(0)" ::: "memory");
  __syncthreads();
  if (threadIdx.x == 0) {
    unsigned* bar = b.bar;
    __builtin_amdgcn_s_waitcnt(0);
    unsigned nloc = b.st[0], nx = b.st[1];
    if (nloc == 0u) { xb_complete(bar, b.x, nloc, nx); b.st[0] = nloc; b.st[1] = nx; }
    const unsigned old = xb_add(&bar[XB_XSUB(b.x)], 1u);
    const unsigned gen = old / nloc;
    if (old + 1u == (gen + 1u) * nloc) {
      __builtin_amdgcn_fence(__ATOMIC_RELEASE, "agent");
      asm volatile("s_waitcnt vmcnt(0)" ::: "memory");
      const unsigned og = xb_add(&bar[XB_TOP], 1u);
      const unsigned tg = og / nx;
      if (og + 1u == (tg + 1u) * nx) xb_add(&bar[XB_TOPGEN], 1u);
      else XB_SPIN(xb_ld(&bar[XB_TOPGEN]) == tg, bar);
      __builtin_amdgcn_fence(__ATOMIC_ACQUIRE, "agent");
      xb_add(&bar[XB_XGEN(b.x)], 1u);
      asm volatile("s_waitcnt vmcnt(0)" ::: "memory");
    } else {
      XB_SPIN(xb_ld(&bar[XB_XGEN(b.x)]) == gen, bar);
      __builtin_amdgcn_fence(__ATOMIC_ACQUIRE, "agent");
      asm volatile("s_waitcnt vmcnt(0)" ::: "memory");
    }
  }
  __syncthreads();
}
#endif

#ifdef HOST_EMU
#define PLOAD(parg) (parg)
#else
DI Params pload_kernarg() {
#if defined(__HIP_DEVICE_COMPILE__)
  const __attribute__((address_space(4))) Params* kp = (const __attribute__((address_space(4))) Params*)__builtin_amdgcn_kernarg_segment_ptr(); asm volatile("" : "+s"(kp)); return *kp;
#else
  return Params{};
#endif
}
#define PLOAD(parg) pload_kernarg()
#endif
#ifndef HOST_EMU
__global__ __launch_bounds__(NTHREADS, 2)
#endif
void fwd_kernel(Params p_arg) {
  char* lds = LDS_PTR();
  GridBar gb; { const Params p = PLOAD(p_arg); gb = gridbar_init(p, lds); }
  const int G = gridDim.x, bid = blockIdx.x;
  for (int rep = 0; rep < REPS(0); ++rep) if (PH_ON(0)) { const Params p = PLOAD(p_arg); phase0(p, lds); }
  grid_sync();
  for (int rep = 0; rep < REPS(1); ++rep) if (PH_ON(1)) { const Params p = PLOAD(p_arg); phase_prenorm(p); }
  gsync(gb);
  for (int rep = 0; rep < REPS(2); ++rep) if (PH_ON(2)) { const Params p = PLOAD(p_arg); const int nM = (NTOK + 255) / 256, nN = (NPROJ + 255) / 256;
    for (int tile = bid; tile < nM * nN; tile += G) { const int mt = tile % nM, nt = tile / nM;
      gemm_tile8(WSP(const bf16_t, h), D_MODEL, NTOK, mt * 256, WSP(const bf16_t, WinT) + (long)nt * 256 * D_MODEL, D_MODEL, NPROJ_VALID - nt * 256, D_MODEL, lds, [&](int hn) { const int q = (nt * 256 + hn * 128) >> 7; return q >= 20 && q < NT_LAST; },
                 [&](const float* st, int m0, int nq) { epi_proj(p, st, m0, nt * 256 + nq); }, [&](int row, int col, const f32x4& v0, const f32x4& v1, int nq) { epid_proj(p, row, col, v0, v1, nt * 256 + nq); }); }
    { const int ntl = nM * nN, rem = ntl % G, nlight = rem ? G - rem : 0; constexpr int KL = 22;
      int part = KL * nlight; if (part > 2 * TAB_N) part = 2 * TAB_N;
      if (nlight && bid >= rem) tab_items(p, lds, bid - rem, nlight, part);
      tab_items(p, lds, part + bid, G, 2 * TAB_N); } }
  gsync(gb);
  for (int rep = 0; rep < REPS(3); ++rep) if (PH_ON(3)) { const Params p = PLOAD(p_arg); constexpr int MC = BATCH * NG * NCP; const int nMc = (MC + 255) / 256, nc = 2 * nMc, nMt = (NTOK + 255) / 256, nq = nMt * (NH * MQK / 256), nkv = nMt * (NH / 2);
    const int hole = G > nc ? nc : 0;
    for (int j = 0;; ++j) { int tile;
      if (j < 2 || !hole) tile = j * G + bid; else { if (bid < hole) break; tile = 2 * G + (j - 2) * (G - hole) + (bid - hole); }
      if (tile >= nc + nq + nkv) break;
      if (tile < nc) { const int which = tile / nMc, mt = tile % nMc;
        gemm_tile8(which == 0 ? WSP(const bf16_t, KcR) : WSP(const bf16_t, VcR), 1024, MC, mt * 256, WSP(const bf16_t, W1T) + (long)which * CMP_HIDDEN * 2048, 2048, CMP_HIDDEN, 2048, lds,
                  [&](int) { return true; }, [&](const float* st, int m0, int nq_) { epi_cmp1(p, st, m0, nq_, which); }, [&](int row, int col, const f32x4& v0, const f32x4& v1, int nq_) { epid_cmp1(p, row, nq_ + col, v0, v1, which); });
      } else if (tile < nc + nq) { const int r = tile - nc, mt = r % nMt, nt = r / nMt; tile_rstd(WSP(const float, cqpart), 16, mt * 256, QR, lds);
        gemm_tile8(WSP(const bf16_t, cq), QR, NTOK, mt * 256, WSP(const bf16_t, WquT) + (long)nt * 256 * QR, QR, 256, QR, lds, [&](int) { return false; }, [&](const float* st, int m0, int nq_) { epi_qup(p, st, m0, nt * 256 + nq_); }, [&](int, int, const f32x4&, const f32x4&, int) {});
      } else { const int r = tile - nc - nq, mt = r % nMt, nt = r / nMt; tile_rstd(WSP(const float, ckvpart), 8, mt * 256, KVR, lds);
        gemm_tile8(WSP(const bf16_t, ckv), KVR, NTOK, mt * 256, WSP(const bf16_t, WkvT) + (long)nt * 256 * KVR, KVR, 256, KVR, lds, [&](int) { return false; }, [&](const float* st, int m0, int nq_) { epi_kvup(p, st, m0, nt * 256 + nq_, lds); }, [&](int, int, const f32x4&, const f32x4&, int) {});
      } }
    late_conv_items(p, lds, bid, G, LC_TOTAL); }
  gsync(gb);
  for (int rep = 0; rep < REPS(4); ++rep) if (PH_ON(4)) { const Params p = PLOAD(p_arg); constexpr int MC = BATCH * NG * NCP; const int nMc = (MC + 255) / 256;
    for (int tile = bid; tile < 2 * nMc; tile += G) { const int which = tile / nMc, mt = tile % nMc;
      gemm_tile(WSP(const bf16_t, hid) + (long)which * MC * CMP_HIDDEN, CMP_HIDDEN, MC, mt * 256, WSP(const bf16_t, W2T) + (long)which * 128 * CMP_HIDDEN, CMP_HIDDEN, 128, CMP_HIDDEN, lds,
                [&](const float* st, int m0, int) { epi_cmp2(p, st, m0, which); }); } }
  gsync(gb);
  for (int rep = 0; rep < REPS(5); ++rep) if (PH_ON(5)) { const Params p = PLOAD(p_arg); const int nN = BATCH * NG * (SEQ / 64), nMl = BATCH * NH * (SEQ / 256), total = nN + nMl;
    for (int j = 0;; ++j) { const long rank = (long)j * G + ((j & 1) ? (G - 1 - bid) : bid); if ((long)j * G >= total) break; if (rank >= total) continue;
      int isn, idx; const int pairs = nN < nMl ? nN : nMl;
      if (rank < 2 * pairs) { isn = (rank & 1) == 0; idx = (int)(rank >> 1); } else { isn = nN > nMl; idx = (int)(rank - pairs); }
#ifdef NO_NSA
      if (0) {}
#else
      if (isn) { const int ti = (SEQ / 64 - 1) - idx / (BATCH * NG), bgx = idx % (BATCH * NG); nsa_tile(p, bgx / NG, bgx % NG, ti * 64, lds); }
#endif
#ifndef NO_MLA
      else { const int ti = (SEQ / 256 - 1) - idx / (BATCH * NH), bh = idx % (BATCH * NH); mla_tile(p, bh / NH, bh % NH, ti * 256, lds); }
#endif
      __syncthreads(); } }
  gsync(gb);
  for (int rep = 0; rep < REPS(6); ++rep) if (PH_ON(6)) { const Params p = PLOAD(p_arg); const int nM = (NTOK + 255) / 256, nN = D_MODEL / 256;
    for (int tile = bid; tile < nM * nN; tile += G) { const int mt = tile % nM, nt = tile / nM;
      const bf16_t* gm = (const bf16_t*)p.out; bf16_t* mg = WSP(bf16_t, merged);
      gemm_tile8_merge(WSP(const bf16_t, on), WSP(const bf16_t, WnT) + (long)nt * 256 * 1024, WSP(const bf16_t, om), WSP(const bf16_t, WmT) + (long)nt * 256 * 1024, 1024, mt * 256, 1024, lds,
        [&](int row, int col, f32x4& g0, f32x4& g1) __attribute__((always_inline)) { const bf16_t* gp = gm + (long)row * (2 * D_MODEL) + nt * 256 + col; const u32x2 a = *(const u32x2*)gp, b = *(const u32x2*)(gp + D_MODEL);
          g0 = (f32x4){bflo(a[0]), bfhi(a[0]), bflo(a[1]), bfhi(a[1])}; g1 = (f32x4){bflo(b[0]), bfhi(b[0]), bflo(b[1]), bfhi(b[1])}; },
        [&](int row, int col, const f32x4& v) __attribute__((always_inline)) { *(u32x2*)(mg + (long)row * D_MODEL + nt * 256 + col) = pack4(v); }); } }
  gsync(gb);
  for (int rep = 0; rep < REPS(7); ++rep) if (PH_ON(7)) { const Params p = PLOAD(p_arg); const int nM = (NTOK + 255) / 256, nN = D_MODEL / 256;
    for (int tile = bid; tile < nM * nN; tile += G) { const int mt = tile % nM, nt = tile / nM;
      gemm_tile8(WSP(const bf16_t, merged), D_MODEL, NTOK, mt * 256, WSP(const bf16_t, WoT) + (long)nt * 256 * D_MODEL, D_MODEL, 256, D_MODEL, lds, [&](int) { return true; }, [&](const float* st, int m0, int nq) { epi_wout(p, st, m0, nt * 256 + nq); }, [&](int row, int col, const f32x4& v0, const f32x4& v1, int nq) { epid_store_bf16(WSP(bf16_t, y), D_MODEL, row, nt * 256 + nq + col, v0, v1); }); } }
  gsync(gb);
  for (int rep = 0; rep < REPS(8); ++rep) if (PH_ON(8)) { const Params p = PLOAD(p_arg); phase_postattn(p); }
  gsync(gb);
  for (int rep = 0; rep < REPS(9); ++rep) if (PH_ON(9)) { const Params p = PLOAD(p_arg); const int nM = (NTOK + 255) / 256, nN = 2048 / 256;
    for (int tile = bid; tile < nM * nN; tile += G) { const int mt = tile % nM, nt = tile / nM;
      gemm_tile8(WSP(const bf16_t, h2), D_MODEL, NTOK, mt * 256, WSP(const bf16_t, WpqT) + (long)nt * 256 * D_MODEL, D_MODEL, 256, D_MODEL, lds, [&](int) { return true; }, [&](const float* st, int m0, int nq) { epi_pq(p, st, m0, nt * 256 + nq); }, [&](int row, int col, const f32x4& v0, const f32x4& v1, int nq) { epid_store_bf16(WSP(bf16_t, qry), 2048, row, nt * 256 + nq + col, v0, v1); }); } }
  gsync(gb);
  for (int rep = 0; rep < REPS(10); ++rep) if (PH_ON(10)) { const Params p = PLOAD(p_arg); const int nM = (NTOK + 255) / 256;
    for (int tile = bid; tile < nM * 16; tile += G) { const int mt = tile % nM, hp = tile / nM;
      gemm_tile(WSP(const bf16_t, qry) + hp * 128, 2048, NTOK, mt * 256, WSP(const bf16_t, SK) + (long)hp * 128 * 128, 128, 128, 128, lds, [&](const float* st, int m0, int) { epi_sc(p, st, m0, hp * 128); }); } }
  gsync(gb);
  for (int rep = 0; rep < REPS(11); ++rep) if (PH_ON(11)) { const Params p = PLOAD(p_arg); phase_peer_topk(p); }
  gsync(gb);
  for (int rep = 0; rep < REPS(12); ++rep) if (PH_ON(12)) { const Params p = PLOAD(p_arg); phase_peer_u(p); }
  gsync(gb);
  for (int rep = 0; rep < REPS(13); ++rep) if (PH_ON(13)) { const Params p = PLOAD(p_arg); phase_peer_w(p); }
  gsync(gb);
  for (int rep = 0; rep < REPS(14); ++rep) if (PH_ON(14)) { const Params p = PLOAD(p_arg); phase_peer_v(p); }
  gsync(gb);
  if (PH_ON(15)) { const Params p = PLOAD(p_arg); phase_peer_final(p); }
}

#ifndef HOST_EMU
extern "C" void kernel_launch(void* const* d_in, const int* in_sizes, int n_in, void* d_out, int out_size, void* d_ws, size_t ws_size, hipStream_t stream) {
  static int grid_blocks = 0;
  if (!grid_blocks) {
    int dev = 0, cus = 0, per_cu = 0;
    (void)hipGetDevice(&dev);
    (void)hipDeviceGetAttribute(&cus, hipDeviceAttributeMultiprocessorCount, dev);
    (void)hipFuncSetAttribute((const void*)fwd_kernel, hipFuncAttributeMaxDynamicSharedMemorySize, LDS_BYTES);
    (void)hipOccupancyMaxActiveBlocksPerMultiprocessor(&per_cu, fwd_kernel, NTHREADS, LDS_BYTES);
    per_cu = 1;
    grid_blocks = cus * per_cu;
  }
  Params p{};
  p.x = (const float*)d_in[0]; p.c = (const float*)d_in[1]; p.pos = (const int*)d_in[2];
  { int i = 3;
    p.ada_w = (const float*)d_in[i++]; p.ada_b = (const float*)d_in[i++]; p.attn_pre_g = (const float*)d_in[i++]; p.attn_post_g = (const float*)d_in[i++];
    p.w_in = (const float*)d_in[i++]; p.cmp_pe = (const float*)d_in[i++]; p.cmp_w1 = (const float*)d_in[i++]; p.cmp_b1 = (const float*)d_in[i++]; p.cmp_w2 = (const float*)d_in[i++];
    p.mla_q_norm_g = (const float*)d_in[i++]; p.mla_w_q_up = (const float*)d_in[i++]; p.mla_kv_norm_g = (const float*)d_in[i++]; p.mla_w_kv_up = (const float*)d_in[i++];
    p.w_branch_nsa = (const float*)d_in[i++]; p.w_branch_mla = (const float*)d_in[i++]; p.w_out = (const float*)d_in[i++]; p.ffn_pre_g = (const float*)d_in[i++]; p.ffn_post_g = (const float*)d_in[i++];
    p.peer_w_q = (const float*)d_in[i++]; p.peer_sub_keys = (const float*)d_in[i++]; p.peer_u = (const float*)d_in[i++]; p.peer_v = (const float*)d_in[i++]; }
  p.out = (float*)d_out; p.ws = (char*)d_ws;
  if (ws_size < WL.total) { fprintf(stderr, "workspace too small: %zu < %zu\n", ws_size, (size_t)WL.total); return; }
  (void)hipMemsetAsync((char*)d_ws + WL.bar, 0, 16384, stream);
  void* args[] = {&p};
  hipError_t e = hipLaunchCooperativeKernel((void*)fwd_kernel, dim3(grid_blocks), dim3(NTHREADS), args, LDS_BYTES, stream);
  if (e != hipSuccess) fprintf(stderr, "cooperative launch failed: %s (grid %d)\n", hipGetErrorString(e), grid_blocks);
}
#endif
```

```cpp
#ifdef HOST_EMU
#include "emu.h"
#else
#include <hip/hip_runtime.h>
#include <hip/hip_cooperative_groups.h>
#include <cstdio>
namespace cg = cooperative_groups;
#endif
#include <stdint.h>

#define DI __device__ __forceinline__

#ifdef SMALL_CFG
constexpr int D_MODEL = 512, BATCH = 1, SEQ = 2048;
#else
constexpr int D_MODEL = 2048, BATCH = 4, SEQ = 4096;
#endif
constexpr int NTOK = BATCH * SEQ;
constexpr int NH = 16, NG = 4, HD = 64;
constexpr int CMP_HIDDEN = 256;
constexpr int NCP = SEQ / 16;
constexpr int NSEL = SEQ / 64;
constexpr int WINDOW = 512;
constexpr int QR = 512, KVR = 256;
constexpr int MQK = 96;
constexpr int PH = 8, PNK = 128, PQD = 256, PTOPK = 16;
constexpr int NEXP = PNK * PNK;
constexpr int NPICK = PH * PTOPK;
constexpr float NORM_EPS = 1e-6f;
constexpr int IN_COLS = 1024 + 1536 + 48 + 512 + 256 + 32 + 2 * D_MODEL;
constexpr int PC_Q = 0, PC_KV = 1024, PC_CQ = 2560, PC_CKV = 3072, PC_GM = 3328, PC_KR = PC_GM + 2 * D_MODEL, PC_GN = PC_KR + 32;
constexpr int NPROJ = ((PC_GN + 48 + 255) / 256) * 256;
constexpr int NPROJ_VALID = ((PC_GN + 48 + 127) / 128) * 128;
constexpr int GMT = 2 * D_MODEL / 128;
constexpr int NT_LAST = 26 + GMT;
static_assert(NPROJ_VALID / 128 == NT_LAST + 1, "proj tiles");
static_assert((NTOK * NG / 16) % 256 == 0 && NTOK % 256 == 0 && SEQ % 256 == 0, "row tiling");

#ifndef PH_MASK
#define PH_MASK 0xFFFF
#endif
#define PH_ON(k) (((PH_MASK) >> (k)) & 1)
#ifndef REP
#define REP (-1)
#endif
#define REPS(k) ((REP) == (k) ? 2 : 1)
constexpr int NTHREADS = 512, NW = NTHREADS / 64;
constexpr int LDS_MAIN = 147456;
constexpr int LDS_BYTES = LDS_MAIN + 256;
constexpr int ST_LD = 129;
constexpr int AB_STR = 144;

typedef unsigned short bf16_t;
typedef short bf16x8 __attribute__((ext_vector_type(8)));
typedef short bf16x4 __attribute__((ext_vector_type(4)));
typedef float f32x16 __attribute__((ext_vector_type(16)));
typedef float f32x4 __attribute__((ext_vector_type(4)));
typedef float f32x2 __attribute__((ext_vector_type(2)));
typedef unsigned u32x4 __attribute__((ext_vector_type(4)));
typedef unsigned u32x2 __attribute__((ext_vector_type(2)));

DI float u2f(unsigned u) { float f; __builtin_memcpy(&f, &u, 4); return f; }
DI unsigned f2u(float f) { unsigned u; __builtin_memcpy(&u, &f, 4); return u; }
DI float bf2f(bf16_t v) { return u2f((unsigned)v << 16); }
DI float bflo(unsigned u) { return u2f(u << 16); }
DI float bfhi(unsigned u) { return u2f(u & 0xffff0000u); }
#ifdef HOST_EMU
DI bf16_t f2bf(float x) { unsigned u = f2u(x); u += 0x7fffu + ((u >> 16) & 1u); return (bf16_t)(u >> 16); }
DI unsigned pack2(float lo, float hi) { return (unsigned)f2bf(lo) | ((unsigned)f2bf(hi) << 16); }
DI float fexp2(float x) { return exp2f(x); }
DI float frcp(float x) { return 1.0f / x; }
DI float frsq(float x) { return 1.0f / sqrtf(x); }
DI float fsin_rev(float x) { return sinf(6.283185307179586f * x); }
DI float fcos_rev(float x) { return cosf(6.283185307179586f * x); }
DI int bcast_i(int v, int l) { return __shfl(v, l); }
DI void grid_sync() { emu_grid_sync(); }
#define LDS_PTR() (emu_cur->blk->smem)
#else
typedef __bf16 bf16v2 __attribute__((ext_vector_type(2)));
DI unsigned pack2(float lo, float hi) { f32x2 v = {lo, hi}; bf16v2 r = __builtin_convertvector(v, bf16v2); return __builtin_bit_cast(unsigned, r); }
DI bf16_t f2bf(float x) { return (bf16_t)(pack2(x, 0.f) & 0xffffu); }
DI float fexp2(float x) { return __builtin_amdgcn_exp2f(x); }
DI float frcp(float x) { return __builtin_amdgcn_rcpf(x); }
DI float frsq(float x) { return __builtin_amdgcn_rsqf(x); }
DI float fsin_rev(float x) { return __builtin_amdgcn_sinf(x); }
DI float fcos_rev(float x) { return __builtin_amdgcn_cosf(x); }
DI int bcast_i(int v, int l) { return __builtin_amdgcn_readlane(v, l); }
DI void grid_sync() { cg::this_grid().sync(); }
extern __shared__ __attribute__((aligned(16))) char dyn_lds[];
#define LDS_PTR() (dyn_lds)
#endif
DI float bcast_f(float v, int l) { return u2f((unsigned)bcast_i((int)f2u(v), l)); }
DI int shfl_i(int v, int l) { return __shfl(v, l); }
DI float shfl_f(float v, int l) { return __shfl(v, l); }
#ifdef HOST_EMU
DI int tid() { return threadIdx.x; }
#else
DI int tid() { int t = threadIdx.x; asm volatile("" : "+v"(t)); return t; }
#endif
#ifdef HOST_EMU
#define GLD16(ptr) (*(const u32x4*)(ptr))
#else
#define GLD16(ptr) (*(const __attribute__((address_space(1))) u32x4*)(const __attribute__((address_space(1))) void*)(ptr))
#endif
DI float fsigmoid(float x) { return frcp(1.0f + fexp2(-1.4426950408889634f * x)); }
DI float fgelu_tanh(float x) { const float z2 = 2.0f * 0.7978845608028654f * (x + 0.044715f * x * x * x); return x * frcp(1.0f + fexp2(-1.4426950408889634f * z2)); }

#ifdef HOST_EMU
DI unsigned emu_f2e4m3(float x) { unsigned sgn = x < 0 ? 0x80u : 0u; float a = fabsf(x); if (!(a == a)) return sgn | 0x7f; if (a > 448.f) a = 448.f;
  if (a < 0.0009765625f) return sgn;
  int e; frexpf(a, &e); int ex = e - 1; if (ex < -6) ex = -6;
  float q = ldexpf(a, 3 - ex); float r = nearbyintf(q);
  if (r >= 16.f) { r = 8.f; ex += 1; }
  unsigned bits; if (r < 8.f) bits = (unsigned)r; else bits = ((unsigned)(ex + 7) << 3) | ((unsigned)r - 8u);
  if (bits > 0x7e) bits = 0x7e; return sgn | bits; }
DI float emu_e4m32f(unsigned b) { const float sg = (b & 0x80u) ? -1.f : 1.f; const unsigned ex = (b >> 3) & 15u, m = b & 7u; if (ex == 0) return sg * ldexpf((float)m, -9); return sg * ldexpf((float)(8 + m), (int)ex - 10); }
DI unsigned enc_fp8x4(float a, float b, float c, float d) { return emu_f2e4m3(a) | (emu_f2e4m3(b) << 8) | (emu_f2e4m3(c) << 16) | (emu_f2e4m3(d) << 24); }
DI f32x2 dec_fp8_lo(unsigned w) { return (f32x2){emu_e4m32f(w & 0xff), emu_e4m32f((w >> 8) & 0xff)}; }
DI f32x2 dec_fp8_hi(unsigned w) { return (f32x2){emu_e4m32f((w >> 16) & 0xff), emu_e4m32f(w >> 24)}; }
#else
DI unsigned enc_fp8x4(float a, float b, float c, float d) { int r = __builtin_amdgcn_cvt_pk_fp8_f32(a, b, 0, false); r = __builtin_amdgcn_cvt_pk_fp8_f32(c, d, r, true); return (unsigned)r; }
DI f32x2 dec_fp8_lo(unsigned w) { return __builtin_amdgcn_cvt_pk_f32_fp8((int)w, false); }
DI f32x2 dec_fp8_hi(unsigned w) { return __builtin_amdgcn_cvt_pk_f32_fp8((int)w, true); }
#endif
DI float wave_sum(float v) { for (int m = 32; m >= 1; m >>= 1) v += __shfl_xor(v, m); return v; }
DI f32x4 mfma16(bf16x8 a, bf16x8 b, f32x4 c) { return __builtin_amdgcn_mfma_f32_16x16x32_bf16(a, b, c, 0, 0, 0); }
DI f32x16 mfma32(bf16x8 a, bf16x8 b, f32x16 c) { return __builtin_amdgcn_mfma_f32_32x32x16_bf16(a, b, c, 0, 0, 0); }
DI int crow(int i, int h) { return (i & 3) + 8 * (i >> 2) + 4 * h; }
DI f32x16 zero16() { f32x16 z; for (int i = 0; i < 16; ++i) z[i] = 0.f; return z; }

constexpr size_t al256(size_t x) { return (x + 255) & ~(size_t)255; }
struct WsLayout {
  size_t bar, uinv, vinv, W1T, W2T, WquT, WkvT, WnT, WmT, WoT, WpqT, SK, U16, V16, cmpbias, ropeN, ropeM, mod, ovlT;
  size_t WinT, h, on, om, h2;
  size_t Qn, KcR, VcR, Ks, Kw, VsT, VwT, gn, cq, ckv, kr, cqpart, ckvpart, merged, qry, yb, pw, ypart2;
  size_t Qm, Km, VmT, hid, Kc, VcT, y, ypart, sc, apart;
  size_t picks;
  size_t total;
};
constexpr WsLayout make_layout() {
  WsLayout L{}; size_t o = 0;
  auto take = [&](size_t bytes) { size_t r = o; o = al256(o + bytes); return r; };
  L.bar = take(16384);
  L.uinv = take((size_t)NEXP * 4); L.vinv = take((size_t)NEXP * 4);
  L.W1T = take((size_t)2 * CMP_HIDDEN * 2048 * 2);
  L.W2T = take((size_t)2 * 128 * CMP_HIDDEN * 2);
  L.WquT = take((size_t)NH * MQK * QR * 2);
  L.WkvT = take((size_t)NH * 128 * KVR * 2);
  L.WnT = take((size_t)D_MODEL * 1024 * 2);
  L.WmT = take((size_t)D_MODEL * 1024 * 2);
  L.WoT = take((size_t)D_MODEL * D_MODEL * 2);
  L.WpqT = take((size_t)2048 * D_MODEL * 2);
  L.SK = take((size_t)16 * 128 * 128 * 2);
  L.U16 = take((size_t)NEXP * D_MODEL * 2);
  L.V16 = take((size_t)NEXP * D_MODEL * 2);
  L.cmpbias = take(2 * CMP_HIDDEN * 4);
  L.ropeN = take((size_t)NTOK * 16 * 4);
  L.ropeM = take((size_t)NTOK * 32 * 4);
  L.mod = take((size_t)BATCH * 6 * D_MODEL * 4);
  L.ovlT = take((size_t)64 * NCP * 2 + 4096);
  size_t r1 = o;
  L.WinT = take((size_t)NPROJ * D_MODEL * 2);
  L.h = take((size_t)NTOK * D_MODEL * 2);
  size_t r1end = o;
  o = r1; L.on = take((size_t)NTOK * 1024 * 2); L.om = take((size_t)NTOK * 1024 * 2);
  if (o > r1end) r1end = o;
  o = r1; L.h2 = take((size_t)NTOK * D_MODEL * 2);
  if (o > r1end) r1end = o;
  o = r1end;
  size_t r2 = o;
  L.Qn = take((size_t)NTOK * 1024 * 2);
  L.KcR = take((size_t)NTOK * 256 * 2 + 8192);
  L.VcR = take((size_t)NTOK * 256 * 2 + 8192);
  L.Ks = take((size_t)NTOK * 256 * 2);
  L.Kw = take((size_t)NTOK * 256 * 2);
  L.VsT = take((size_t)NTOK * 256 * 2);
  L.VwT = take((size_t)NTOK * 256 * 2);
  L.gn = take((size_t)NTOK * 48 * 4);
  L.cq = take((size_t)NTOK * QR * 2);
  L.ckv = take((size_t)NTOK * KVR * 2);
  L.kr = take((size_t)NTOK * 32 * 4);
  L.cqpart = take((size_t)16 * NTOK * 4);
  L.ckvpart = take((size_t)8 * NTOK * 4);
  size_t r2end = o;
  o = r2; L.merged = take((size_t)NTOK * D_MODEL * 2); if (o > r2end) r2end = o;
  o = r2; L.qry = take((size_t)NTOK * 2048 * 2); if (o > r2end) r2end = o;
  o = r2; L.yb = take((size_t)NTOK * D_MODEL * 2); L.pw = take((size_t)NTOK * NPICK * 4); L.ypart2 = take((size_t)(D_MODEL / 128) * NTOK * 4); if (o > r2end) r2end = o;
  o = r2end;
  size_t r3 = o;
  L.Qm = take((size_t)NTOK * NH * MQK * 2);
  L.Km = take((size_t)NTOK * NH * MQK * 2);
  L.VmT = take((size_t)NTOK * NH * 64 * 2);
  L.hid = take((size_t)2 * BATCH * NG * NCP * CMP_HIDDEN * 2);
  L.Kc = take((size_t)BATCH * NG * NCP * 64 * 2 + 16384);
  L.VcT = take((size_t)BATCH * NG * 64 * NCP * 2 + 16384);
  size_t r3end = o;
  o = r3; L.y = take((size_t)NTOK * D_MODEL * 2); L.ypart = take((size_t)(D_MODEL / 128) * NTOK * 4); if (o > r3end) r3end = o;
  o = r3; L.sc = take((size_t)NTOK * 2048 * 4); if (o > r3end) r3end = o;
  o = r3; L.apart = take((size_t)(D_MODEL / 128) * NTOK * NPICK * 2); if (o > r3end) r3end = o;
  o = r3end;
  L.picks = take((size_t)NTOK * NPICK * 8);
  L.total = o;
  return L;
}
constexpr WsLayout WL = make_layout();

struct Params {
  const float *x, *c; const int* pos;
  const float *ada_w, *ada_b, *attn_pre_g, *attn_post_g, *w_in, *cmp_pe, *cmp_w1, *cmp_b1, *cmp_w2, *mla_q_norm_g, *mla_w_q_up,
      *mla_kv_norm_g, *mla_w_kv_up, *w_branch_nsa, *w_branch_mla, *w_out, *ffn_pre_g, *ffn_post_g, *peer_w_q, *peer_sub_keys, *peer_u, *peer_v;
  float* out; char* ws;
};
#define WSP(T, name) ((T*)(p.ws + WL.name))

#ifdef HOST_EMU
DI void glds16(const void* g, char* lds_wave_base) { __builtin_memcpy(lds_wave_base + (tid() & 63) * 16, g, 16); }
#else
DI void glds16(const void* g, char* lds_wave_base) { __builtin_amdgcn_global_load_lds((const unsigned*)g, (unsigned*)lds_wave_base, 16, 0, 0); }
#endif
#ifdef HOST_EMU
#define SCHED_FENCE() do {} while (0)
DI void wait_vm4() {} DI void wait_vm0() {} DI void raw_barrier() { __syncthreads(); }
#else
#define SCHED_FENCE() __builtin_amdgcn_sched_barrier(0)
DI void wait_vm4() { asm volatile("s_waitcnt vmcnt(4)" ::: "memory"); }
DI void wait_vm0() { asm volatile("s_waitcnt vmcnt(0)" ::: "memory"); }
DI void raw_barrier() { asm volatile("s_waitcnt lgkmcnt(0)" ::: "memory"); __builtin_amdgcn_s_barrier(); asm volatile("" ::: "memory"); }
#endif
struct GemmAcc { f32x16 a[4][2]; };
template <int GV> DI f32x16 mfmaV(bf16x8 a, bf16x8 b, f32x16 c) { if (GV & 2) { c[0] += __builtin_bit_cast(float, (int)a[0] + (int)b[0]); return c; } return mfma32(a, b, c); }
template <int GV = 0  > DI void gemm_mainloop(const bf16_t* Ap, long lda, int mrows  , const bf16_t* Bp, long ldb, int nrows  , int K, char* lds, GemmAcc& G) {
  const int t = tid(), w = t >> 6, l = t & 63, wm = w >> 2, wn = w & 3, lr = l & 31, lh = l >> 5;
#pragma unroll
  for (int i = 0; i < 4; ++i)
#pragma unroll
    for (int j = 0; j < 2; ++j) G.a[i][j] = zero16();
  const int nk = K >> 5;
  constexpr int TA = 256 * 64, SB = 2 * TA;
  const bf16_t* ag[2]; const bf16_t* bgp[2];
#pragma unroll
  for (int i = 0; i < 2; ++i) { const int row = 32 * w + 16 * i + (l >> 2); const int c = (l & 3) ^ ((row >> 2) & 3);
    const int ra = row < mrows ? row : mrows - 1, rb = row < nrows ? row : nrows - 1; ag[i] = Ap + (long)ra * lda + c * 8; bgp[i] = Bp + (long)rb * ldb + c * 8; }
  char* s0 = lds; char* s1 = lds + SB; char* s2 = lds + 2 * SB;
#pragma unroll
  for (int pre = 0; pre < 2; ++pre) { char* sb = (pre ? s1 : s0) + (2 * w) * 1024; const int kc = pre < nk ? pre : nk - 1;
#pragma unroll
    for (int i = 0; i < 2; ++i) { if (!(GV & 1)) { glds16(ag[i] + kc * 32, sb + i * 1024); glds16(bgp[i] + kc * 32, sb + TA + i * 1024); } } }
  const int arow = wm * 128 + lr, brow = wn * 64 + lr;
  const int asw = (arow >> 2) & 3, bsw = (brow >> 2) & 3;
  const int ca0 = ((0 + lh) ^ asw) << 4, ca1 = ((2 + lh) ^ asw) << 4, cb0 = ((0 + lh) ^ bsw) << 4, cb1 = ((2 + lh) ^ bsw) << 4;
  for (int kt = 0; kt < nk; ++kt) {
    wait_vm4();
    raw_barrier();
    const char* const cA = s0; const char* const cB = cA + TA;
    const int kn = kt + 2 < nk ? kt + 2 : nk - 1;
    const int ko = kn * 32; char* const nsA = s2 + (2 * w) * 1024; char* const nsB = nsA + TA;
    bf16x8 a0[4], a1[4];
    const bf16x8 b00 = *(const bf16x8*)(cB + brow * 64 + cb0), b01 = *(const bf16x8*)(cB + (brow + 32) * 64 + cb0);
#pragma unroll
    for (int mi = 0; mi < 4; ++mi) a0[mi] = *(const bf16x8*)(cA + (arow + 32 * mi) * 64 + ca0);
    const bf16x8 b10 = *(const bf16x8*)(cB + brow * 64 + cb1), b11 = *(const bf16x8*)(cB + (brow + 32) * 64 + cb1);
#pragma unroll
    for (int mi = 0; mi < 4; ++mi) a1[mi] = *(const bf16x8*)(cA + (arow + 32 * mi) * 64 + ca1);
    SCHED_FENCE();
    G.a[0][0] = mfmaV<GV>(a0[0], b00, G.a[0][0]); G.a[0][1] = mfmaV<GV>(a0[0], b01, G.a[0][1]); SCHED_FENCE(); if (!(GV & 1)) glds16(ag[0] + ko, nsA); SCHED_FENCE();
    G.a[1][0] = mfmaV<GV>(a0[1], b00, G.a[1][0]); G.a[1][1] = mfmaV<GV>(a0[1], b01, G.a[1][1]);
    G.a[2][0] = mfmaV<GV>(a0[2], b00, G.a[2][0]); G.a[2][1] = mfmaV<GV>(a0[2], b01, G.a[2][1]); SCHED_FENCE(); if (!(GV & 1)) glds16(ag[1] + ko, nsA + 1024); SCHED_FENCE();
    G.a[3][0] = mfmaV<GV>(a0[3], b00, G.a[3][0]); G.a[3][1] = mfmaV<GV>(a0[3], b01, G.a[3][1]);
    G.a[0][0] = mfmaV<GV>(a1[0], b10, G.a[0][0]); G.a[0][1] = mfmaV<GV>(a1[0], b11, G.a[0][1]); SCHED_FENCE(); if (!(GV & 1)) glds16(bgp[0] + ko, nsB); SCHED_FENCE();
    G.a[1][0] = mfmaV<GV>(a1[1], b10, G.a[1][0]); G.a[1][1] = mfmaV<GV>(a1[1], b11, G.a[1][1]);
    G.a[2][0] = mfmaV<GV>(a1[2], b10, G.a[2][0]); G.a[2][1] = mfmaV<GV>(a1[2], b11, G.a[2][1]); SCHED_FENCE(); if (!(GV & 1)) glds16(bgp[1] + ko, nsB + 1024); SCHED_FENCE();
    G.a[3][0] = mfmaV<GV>(a1[3], b10, G.a[3][0]); G.a[3][1] = mfmaV<GV>(a1[3], b11, G.a[3][1]);
    SCHED_FENCE();
    char* const tmp = s0; s0 = s1; s1 = s2; s2 = tmp;
  }
  wait_vm0();
  raw_barrier();
}
namespace g8 {
constexpr int BK = 64, HALF = 128, HT = HALF * BK;
DI int lds_byte(int r, int c) { const int st = (r >> 4) * 2 + (c >> 5), rr = r & 15, cc = c & 31, ob = rr * 64 + cc * 2; return st * 1024 + (ob ^ (((ob >> 9) & 1) << 5)); }
DI void stage_rc(int b, int& R, int& C) { const int st = b / 1024, sb = b % 1024, swz = sb ^ (((sb >> 9) & 1) << 5); R = (st >> 1) * 16 + swz / 64; C = (st & 1) * 32 + (swz % 64) / 2; }
}
#ifdef HOST_EMU
#define G8_WAIT_V(n) do {} while (0)
#define G8_WAIT_L(n) do {} while (0)
#define G8_BAR __syncthreads()
#define G8_SCHED do {} while (0)
#define G8_PRIO(x) do {} while (0)
#else
#define G8_WAIT_V(n) asm volatile("s_waitcnt vmcnt(" #n ")" ::: "memory")
#define G8_WAIT_L(n) asm volatile("s_waitcnt lgkmcnt(" #n ")" ::: "memory")
#define G8_BAR __builtin_amdgcn_s_barrier()
#define G8_SCHED __builtin_amdgcn_sched_barrier(0)
#define G8_PRIO(x) __builtin_amdgcn_s_setprio(x)
#endif
struct GemmAcc8 { f32x4 a[2][2][4][2]; };
struct NoMid { DI void operator()(GemmAcc8&) const {} };
template <bool SPLIT = false, class MidF = NoMid> DI void gemm_mainloop8(const bf16_t* A, long lda, int mrows, const bf16_t* Bt, long ldb, int nrows, int K, char* lds, GemmAcc8& G,
                                                                        const bf16_t* A2 = nullptr, const bf16_t* Bt2 = nullptr, int ksplit = 0, MidF mid = MidF()) {
  using namespace g8;
  bf16_t* shm = (bf16_t*)lds;
  const int tx = tid(); const int wid = tx >> 6, lane = tx & 63, wr = wid >> 2, wc = wid & 3, fr = lane & 15, fq = lane >> 4;
#define G8_SA(b, h) (shm + ((b) * 2 + (h)) * HT)
#define G8_SB(b, h) (shm + (4 + (b) * 2 + (h)) * HT)
  unsigned oA[2], oB[2];
#pragma unroll
  for (int i = 0; i < 2; ++i) { int r_, c_; stage_rc(tx * 16 + i * 8192, r_, c_); oA[i] = (unsigned)(r_ * (int)lda + c_) * 2u; oB[i] = (unsigned)(r_ * (int)ldb + c_) * 2u; }
  const int wbase = __builtin_amdgcn_readfirstlane((tx & ~63) * 16);
#define G8_STAGE(P, BASE, LD, br, OFF, kt) do { const bf16_t* _ub = ((SPLIT && (kt) >= ksplit) ? ((BASE) == A ? A2 : Bt2) + (long)((kt) - ksplit) * BK : (BASE) + (long)(kt) * BK) + (long)(br) * (LD); _Pragma("unroll") for (int _i = 0; _i < 2; ++_i) \
    glds16((const char*)_ub + OFF[_i], (char*)(P) + wbase + _i * 8192); } while (0)
#define G8_LDA(dst, b, h) _Pragma("unroll") for (int m = 0; m < 4; ++m) _Pragma("unroll") for (int k = 0; k < 2; ++k) \
    dst[m][k] = *(const bf16x8*)((const char*)G8_SA(b, h) + lds_byte(wr * 64 + m * 16 + fr, k * 32 + fq * 8))
#define G8_LDB(dst, b, h) _Pragma("unroll") for (int n = 0; n < 2; ++n) _Pragma("unroll") for (int k = 0; k < 2; ++k) \
    dst[n][k] = *(const bf16x8*)((const char*)G8_SB(b, h) + lds_byte(wc * 32 + n * 16 + fr, k * 32 + fq * 8))
#define G8_MMA(ai, bj, At, Bq) do { G8_PRIO(1); _Pragma("unroll") for (int m = 0; m < 4; ++m) _Pragma("unroll") for (int n = 0; n < 2; ++n) _Pragma("unroll") for (int k = 0; k < 2; ++k) \
    G.a[ai][bj][m][n] = mfma16(Bq[n][k], At[m][k], G.a[ai][bj][m][n]); G8_PRIO(0); } while (0)
#pragma unroll
  for (int ai = 0; ai < 2; ++ai)
#pragma unroll
    for (int bj = 0; bj < 2; ++bj)
#pragma unroll
      for (int m = 0; m < 4; ++m)
#pragma unroll
        for (int n = 0; n < 2; ++n) G.a[ai][bj][m][n] = (f32x4){0.f, 0.f, 0.f, 0.f};
  bf16x8 At[4][2], B0[2][2], B1[2][2];
  const int nt = K / BK;
  G8_STAGE(G8_SB(0, 0), Bt, ldb, 0, oB, 0); G8_STAGE(G8_SA(0, 0), A, lda, 0, oA, 0);
  G8_STAGE(G8_SB(0, 1), Bt, ldb, HALF, oB, 0); G8_STAGE(G8_SA(0, 1), A, lda, HALF, oA, 0);
  if (wr == 1) G8_BAR;
  G8_WAIT_V(4); G8_BAR;
  G8_STAGE(G8_SB(1, 0), Bt, ldb, 0, oB, 1); G8_STAGE(G8_SA(1, 0), A, lda, 0, oA, 1); G8_STAGE(G8_SB(1, 1), Bt, ldb, HALF, oB, 1);
  G8_WAIT_V(6); G8_BAR;
  for (int t = 0; t < nt - 2; t += 2) {
    G8_LDB(B0, 0, 0); G8_SCHED; G8_LDA(At, 0, 0); G8_STAGE(G8_SA(1, 1), A, lda, HALF, oA, t + 1);
    G8_WAIT_L(8); G8_BAR; G8_WAIT_L(0); G8_MMA(0, 0, At, B0); G8_BAR; G8_SCHED;
    G8_LDB(B1, 0, 1); G8_STAGE(G8_SB(0, 0), Bt, ldb, 0, oB, t + 2);
    G8_BAR; G8_WAIT_L(0); G8_MMA(0, 1, At, B1); G8_BAR;
    G8_LDA(At, 0, 1); G8_STAGE(G8_SA(0, 0), A, lda, 0, oA, t + 2);
    G8_BAR; G8_WAIT_L(0); G8_MMA(1, 0, At, B0); G8_BAR; G8_SCHED;
    G8_STAGE(G8_SB(0, 1), Bt, ldb, HALF, oB, t + 2);
    G8_WAIT_V(6); G8_BAR; G8_MMA(1, 1, At, B1); G8_BAR;
    G8_LDB(B0, 1, 0); G8_SCHED; G8_LDA(At, 1, 0); G8_STAGE(G8_SA(0, 1), A, lda, HALF, oA, t + 2);
    G8_WAIT_L(8); G8_BAR; G8_WAIT_L(0); G8_MMA(0, 0, At, B0); G8_BAR; G8_SCHED;
    G8_LDB(B1, 1, 1); G8_STAGE(G8_SB(1, 0), Bt, ldb, 0, oB, t + 3);
    G8_BAR; G8_WAIT_L(0); G8_MMA(0, 1, At, B1); G8_BAR;
    G8_LDA(At, 1, 1); G8_STAGE(G8_SA(1, 0), A, lda, 0, oA, t + 3);
    G8_BAR; G8_WAIT_L(0); G8_MMA(1, 0, At, B0); G8_BAR; G8_SCHED;
    G8_STAGE(G8_SB(1, 1), Bt, ldb, HALF, oB, t + 3);
    G8_WAIT_V(6); G8_BAR; G8_MMA(1, 1, At, B1); G8_BAR;
    if (SPLIT && t + 2 == ksplit) mid(G);
  }
  { G8_LDB(B0, 0, 0); G8_LDA(At, 0, 0); G8_STAGE(G8_SA(1, 1), A, lda, HALF, oA, nt - 1);
    G8_BAR; G8_WAIT_L(0); G8_MMA(0, 0, At, B0); G8_BAR;
    G8_LDB(B1, 0, 1); G8_BAR; G8_WAIT_L(0); G8_MMA(0, 1, At, B1); G8_BAR;
    G8_LDA(At, 0, 1); G8_WAIT_V(4); G8_BAR; G8_WAIT_L(0); G8_MMA(1, 0, At, B0); G8_MMA(1, 1, At, B1); G8_BAR; }
  { G8_LDB(B0, 1, 0); G8_LDA(At, 1, 0); G8_WAIT_V(2); G8_BAR; G8_WAIT_L(0); G8_MMA(0, 0, At, B0); G8_BAR;
    G8_LDB(B1, 1, 1); G8_WAIT_V(0); G8_BAR; G8_WAIT_L(0); G8_MMA(0, 1, At, B1); G8_BAR;
    G8_LDA(At, 1, 1); G8_BAR; G8_WAIT_L(0); G8_MMA(1, 0, At, B0); G8_MMA(1, 1, At, B1); G8_BAR; }
  if (wr == 0) G8_BAR;
  __syncthreads();
}
DI void gemm_stage_quarter8(const GemmAcc8& G, int ai, int bj, char* lds) {
  const int tx = tid(); const int wid = tx >> 6, lane = tx & 63, wr = wid >> 2, wc = wid & 3, fr = lane & 15, fq = lane >> 4;
  float* st = (float*)lds;
#pragma unroll
  for (int m = 0; m < 4; ++m)
#pragma unroll
    for (int n = 0; n < 2; ++n)
#pragma unroll
      for (int j = 0; j < 4; ++j) st[(wr * 64 + m * 16 + fr) * ST_LD + wc * 32 + n * 16 + fq * 4 + j] = G.a[ai][bj][m][n][j];
  __syncthreads();
}
template <class EpiD> DI void gemm_direct_quarter8(const GemmAcc8& G, int ai, int bj, int row0, EpiD epid) {
  const int tx = tid(); const int wid = tx >> 6, lane = tx & 63, wr = wid >> 2, wc = wid & 3, fr = lane & 15, fq = lane >> 4;
#pragma unroll
  for (int m = 0; m < 4; ++m) epid(row0 + wr * 64 + m * 16 + fr, wc * 32 + fq * 4, G.a[ai][bj][m][0], G.a[ai][bj][m][1]);
}
template <class Sel, class Epi, class EpiD> DI void gemm_tile8(const bf16_t* A, long lda, int M, int m0, const bf16_t* Bp, long ldb, int ncols, int K, char* lds, Sel direct, Epi epi, EpiD epid) {
  GemmAcc8 G; gemm_mainloop8(A + (long)m0 * lda, lda, M - m0, Bp, ldb, ncols, K, lds, G);
#pragma unroll
  for (int hm = 0; hm < 2; ++hm)
#pragma unroll
    for (int hn = 0; hn < 2; ++hn) { if (m0 + hm * 128 < M && hn * 128 < ncols) {
        if (direct(hn)) gemm_direct_quarter8(G, hm, hn, m0 + hm * 128, [&](int row, int col, const f32x4& v0, const f32x4& v1) __attribute__((always_inline)) { epid(row, col, v0, v1, hn * 128); });
        else { gemm_stage_quarter8(G, hm, hn, lds); epi((const float*)lds, m0 + hm * 128, hn * 128); __syncthreads(); } } }
}

DI void gemm_stage_quarter(const GemmAcc& G, int hm, int hn, char* lds) {
  const int t = tid(), w = t >> 6, l = t & 63, wm = w >> 2, wn = w & 3, lr = l & 31, lh = l >> 5;
  float* st = (float*)lds;
  if (wm == hm && (wn >> 1) == hn) {
#pragma unroll
    for (int mi = 0; mi < 4; ++mi)
#pragma unroll
      for (int ni = 0; ni < 2; ++ni)
#pragma unroll
        for (int i = 0; i < 16; ++i) st[(mi * 32 + crow(i, lh)) * ST_LD + (wn & 1) * 64 + ni * 32 + lr] = G.a[mi][ni][i];
  }
  __syncthreads();
}
template <int GV = 0, class Epi> DI void gemm_tile(const bf16_t* A, long lda, int M, int m0, const bf16_t* Bp, long ldb, int ncols  , int K, char* lds, Epi epi) {
  GemmAcc G; gemm_mainloop<GV>(A + (long)m0 * lda, lda, M - m0, Bp, ldb, ncols, K, lds, G);
#pragma unroll
  for (int hm = 0; hm < 2; ++hm)
#pragma unroll
    for (int hn = 0; hn < 2; ++hn) { if (m0 + hm * 128 < M && hn * 128 < ncols) { gemm_stage_quarter(G, hm, hn, lds); epi((const float*)lds, m0 + hm * 128, hn * 128); } __syncthreads(); }
}

template <class GateF, class StoreF> DI void gemm_tile8_merge(const bf16_t* A1, const bf16_t* B1, const bf16_t* A2, const bf16_t* B2, long ld, int m0, int K1, char* lds, GateF gates, StoreF store) {
  GemmAcc8 G;
  auto lanepos = [&](int& row, int& col, int ai, int bj, int m, int n) __attribute__((always_inline)) { const int tx = tid(); const int wid = tx >> 6, lane = tx & 63, wr = wid >> 2, wc = wid & 3, fr = lane & 15, fq = lane >> 4;
    row = m0 + ai * 128 + wr * 64 + m * 16 + fr; col = bj * 128 + wc * 32 + n * 16 + fq * 4; };
  auto mid = [&](GemmAcc8& Gm) __attribute__((always_inline)) {
#pragma unroll
    for (int ai = 0; ai < 2; ++ai)
#pragma unroll
      for (int bj = 0; bj < 2; ++bj)
#pragma unroll
        for (int m = 0; m < 4; ++m)
#pragma unroll
          for (int n = 0; n < 2; ++n) { int row, col; lanepos(row, col, ai, bj, m, n); f32x4 g0, g1; gates(row, col, g0, g1);
#pragma unroll
            for (int j = 0; j < 4; ++j) Gm.a[ai][bj][m][n][j] *= g0[j] * frcp(g1[j]); } };
  gemm_mainloop8<true>(A1 + (long)m0 * ld, ld, 256, B1, ld, 256, 2 * K1, lds, G, A2 + (long)m0 * ld, B2, K1 / 64, mid);
#pragma unroll
  for (int ai = 0; ai < 2; ++ai)
#pragma unroll
    for (int bj = 0; bj < 2; ++bj)
#pragma unroll
      for (int m = 0; m < 4; ++m)
#pragma unroll
        for (int n = 0; n < 2; ++n) { int row, col; lanepos(row, col, ai, bj, m, n); f32x4 g0, g1; gates(row, col, g0, g1); store(row, col, G.a[ai][bj][m][n] * g1); }
}

DI float rope_n(const float* st, int row, int c, const float* rt  ) {
  const int d = c & 63; const float xv = st[row * ST_LD + c];
  if (d >= 16) return xv;
  const int i = d & 7; const float cs = rt[i], sn = rt[8 + i];
  if (d < 8) return xv * cs - st[row * ST_LD + c + 8] * sn;
  return xv * cs + st[row * ST_LD + c - 8] * sn;
}

DI void epi_proj(const Params& p, const float* st, int m0, int n0) {
  const int t = tid(), w = t >> 6, l = t & 63, c = 2 * l;
  const int nt = n0 >> 7, b = m0 / SEQ, t0 = m0 % SEQ;
  const float* ropeN = WSP(const float, ropeN);
  if (nt < 8) {
    bf16_t* Qn = WSP(bf16_t, Qn);
    _Pragma("nounroll") for (int it = 0; it < 128 / NW; ++it) { const int row = it * NW + w; const long tok = m0 + row; const float* rt = ropeN + tok * 16;
      *(unsigned*)(Qn + tok * 1024 + n0 + c) = pack2(rope_n(st, row, c, rt), rope_n(st, row, c + 1, rt)); }
  } else if (nt < 20) {
    const int chunk = (nt - 8) >> 1, g = ((nt - 8) & 1) * 2 + (c >> 6), d = c & 63;
    if (chunk == 0 || chunk == 1 || chunk == 2 || chunk == 4) {
      bf16_t* dst = chunk == 0 ? WSP(bf16_t, KcR) : chunk == 1 ? WSP(bf16_t, VcR) : chunk == 2 ? WSP(bf16_t, Ks) : WSP(bf16_t, Kw);
      const bool rp = (chunk != 1);
      _Pragma("nounroll") for (int it = 0; it < 128 / NW; ++it) { const int row = it * NW + w; const long tok = m0 + row; const float* rt = ropeN + tok * 16;
        float v0, v1; if (rp) { v0 = rope_n(st, row, c, rt); v1 = rope_n(st, row, c + 1, rt); } else { v0 = st[row * ST_LD + c]; v1 = st[row * ST_LD + c + 1]; }
        *(unsigned*)(dst + (((long)(b * NG + g) * SEQ + t0 + row) * 64 + d)) = pack2(v0, v1); }
    } else {
      bf16_t* dst = chunk == 3 ? WSP(bf16_t, VsT) : WSP(bf16_t, VwT);
      _Pragma("nounroll") for (int it = 0; it < 128 / NW; ++it) { const int col = it * NW + w; const int gg = ((nt - 8) & 1) * 2 + (col >> 6), dd = col & 63;
        *(unsigned*)(dst + ((long)((b * NG + gg) * 64 + dd) * SEQ + t0 + 2 * l)) = pack2(st[(2 * l) * ST_LD + col], st[(2 * l + 1) * ST_LD + col]); }
    }
  } else if (nt < 26) {
    const bool isq = nt < 24; const int j = isq ? nt - 20 : nt - 24; const int ld = isq ? QR : KVR;
    bf16_t* dst = isq ? WSP(bf16_t, cq) : WSP(bf16_t, ckv); float* part = isq ? WSP(float, cqpart) : WSP(float, ckvpart);
    _Pragma("nounroll") for (int it = 0; it < 128 / NW; ++it) { const int row = it * NW + w; const long tok = m0 + row;
      *(unsigned*)(dst + tok * ld + j * 128 + c) = pack2(st[row * ST_LD + c], st[row * ST_LD + c + 1]); }
    if (t < 128) { float sq = 0.f;
#pragma unroll 8
      for (int cc = 0; cc < 128; ++cc) { const float v = st[t * ST_LD + cc]; sq += v * v; }
      part[(long)j * NTOK + m0 + t] = sq; }
  } else if (nt < NT_LAST) {
    bf16_t* gm = (bf16_t*)p.out;
    _Pragma("nounroll") for (int it = 0; it < 128 / NW; ++it) { const int row = it * NW + w; const long tok = m0 + row;
      *(unsigned*)(gm + tok * (2 * D_MODEL) + (nt - 26) * 128 + c) = pack2(fsigmoid(st[row * ST_LD + c]), fsigmoid(st[row * ST_LD + c + 1])); }
  } else {
    float* kr = WSP(float, kr); float* gn = WSP(float, gn); const float* ropeM = WSP(const float, ropeM);
    _Pragma("nounroll") for (int it = 0; it < 128 / NW; ++it) { const int row = it * NW + w; const long tok = m0 + row;
      if (l < 32) { const int i = l & 15; const float cs = ropeM[tok * 32 + i], sn = ropeM[tok * 32 + 16 + i]; const float x1 = st[row * ST_LD + i], x2 = st[row * ST_LD + 16 + i];
        kr[tok * 32 + l] = (l < 16) ? x1 * cs - x2 * sn : x2 * cs + x1 * sn; }
      if (l < 48) gn[tok * 48 + l] = fsigmoid(st[row * ST_LD + 32 + l]); }
  }
}

DI void epi_cmp1(const Params& p, const float* st, int m0, int n0, int which) {
  const int t = tid(), w = t >> 6, l = t & 63, c = 2 * l;
  const float* bias = WSP(const float, cmpbias) + which * CMP_HIDDEN; bf16_t* hid = WSP(bf16_t, hid) + (size_t)which * BATCH * NG * NCP * CMP_HIDDEN;
  const float b0 = bias[n0 + c], b1 = bias[n0 + c + 1];
  _Pragma("nounroll") for (int it = 0; it < 128 / NW; ++it) { const int row = it * NW + w;
    *(unsigned*)(hid + (long)(m0 + row) * CMP_HIDDEN + n0 + c) = pack2(fgelu_tanh(st[row * ST_LD + c] + b0), fgelu_tanh(st[row * ST_LD + c + 1] + b1)); }
}
DI void epi_cmp2(const Params& p, const float* st, int m0, int which) {
  const int t = tid(), w = t >> 6, l = t & 63;
  if (which == 0) { bf16_t* Kc = WSP(bf16_t, Kc); const int c = 2 * l;
    if (l < 32) _Pragma("nounroll") for (int it = 0; it < 128 / NW; ++it) { const int row = it * NW + w; const int m = m0 + row; const bool bad = (m % NCP) == NCP - 1;
      *(unsigned*)(Kc + (long)m * 64 + c) = bad ? 0u : pack2(st[row * ST_LD + c], st[row * ST_LD + c + 1]); }
  } else { bf16_t* VcT = WSP(bf16_t, VcT);
    _Pragma("nounroll") for (int it = 0; it < 64 / NW; ++it) { const int d = it * NW + w;
      for (int half = 0; half < 2; ++half) { const int row = 2 * l + half; const int m = m0 + row; const int bg = m / NCP, n = m % NCP; const bool bad = n == NCP - 1;
        VcT[((long)bg * 64 + d) * NCP + n] = bad ? (bf16_t)0 : f2bf(st[row * ST_LD + d]); } }
  }
}
DI float row_rstd(const float* part, int nparts, long tok, int dim) { float s = 0.f; for (int j = 0; j < nparts; ++j) s += part[(long)j * NTOK + tok]; return frsq(s / (float)dim + NORM_EPS); }

constexpr int RS_OFF = 131072;
DI void tile_rstd(const float* part, int nparts, int m0, int dim, char* lds) { const int t = tid(); __syncthreads();
  if (t < 256) ((float*)(lds + RS_OFF))[t] = row_rstd(part, nparts, m0 + t, dim); }
DI void epi_qup(const Params& p, const float* st, int m0, int n0) {
  const int t = tid(), w = t >> 6, l = t & 63, c = 2 * l;
  bf16_t* Qm = WSP(bf16_t, Qm); const float* ropeM = WSP(const float, ropeM); const float* part = WSP(const float, cqpart);
  const int col = n0 + c, dd = col % MQK;
  const float* rsl = (const float*)((const char*)st + RS_OFF) + (m0 & 255);
  _Pragma("nounroll") for (int it = 0; it < 128 / NW; ++it) { const int row = it * NW + w; const long tok = m0 + row; const float rs = rsl[row];
    float v0 = st[row * ST_LD + c], v1 = st[row * ST_LD + c + 1];
    if (dd >= 64) { const int i = dd - 64; const float* rt = ropeM + tok * 32;
      if (i < 16) { const float p0 = st[row * ST_LD + c + 16], p1 = st[row * ST_LD + c + 17]; v0 = v0 * rt[i] - p0 * rt[16 + i]; v1 = v1 * rt[i + 1] - p1 * rt[16 + i + 1]; }
      else { const int k = i - 16; const float p0 = st[row * ST_LD + c - 16], p1 = st[row * ST_LD + c - 15]; v0 = v0 * rt[k] + p0 * rt[16 + k]; v1 = v1 * rt[k + 1] + p1 * rt[16 + k + 1]; } }
    *(unsigned*)(Qm + tok * (NH * MQK) + col) = pack2(v0 * rs, v1 * rs); }
}
DI void epi_kvup(const Params& p, const float* st, int m0, int n0, char* lds) {
  const int t = tid(), w = t >> 6, l = t & 63, c = 2 * l;
  const int hd = n0 >> 7, b = m0 / SEQ, t0 = m0 % SEQ;
  bf16_t* Km = WSP(bf16_t, Km); bf16_t* VmT = WSP(bf16_t, VmT); const float* kr = WSP(const float, kr); const float* part = WSP(const float, ckvpart);
  const float* rsl = (const float*)(lds + RS_OFF) + (m0 & 255);
  { const int row = t >> 2, i = (t & 3) * 8; const float* src = kr + (long)(m0 + row) * 32 + i; const f32x4 x0 = *(const f32x4*)src, x1 = *(const f32x4*)(src + 4);
    *(u32x4*)(Km + ((long)(b * NH + hd) * SEQ + t0 + row) * MQK + 64 + i) = (u32x4){pack2(x0[0], x0[1]), pack2(x0[2], x0[3]), pack2(x1[0], x1[1]), pack2(x1[2], x1[3])}; }
  _Pragma("nounroll") for (int it = 0; it < 64 / NW; ++it) { const int row = (it * NW + w) * 2 + (l >> 5), ck = 2 * (l & 31); const float rs = rsl[row];
    bf16_t* dst = Km + ((long)(b * NH + hd) * SEQ + t0 + row) * MQK;
    *(unsigned*)(dst + ck) = pack2(st[row * ST_LD + ck] * rs, st[row * ST_LD + ck + 1] * rs); }
  _Pragma("nounroll") for (int it = 0; it < 64 / NW; ++it) { const int d = it * NW + w; const int col = 64 + d;
    *(unsigned*)(VmT + ((long)((b * NH + hd) * 64 + d) * SEQ + t0 + 2 * l)) = pack2(st[(2 * l) * ST_LD + col] * rsl[2 * l], st[(2 * l + 1) * ST_LD + col] * rsl[2 * l + 1]); }
}
DI void epi_merge(const Params& p, const float* st, int m0, int n0, int which) {
  const int t = tid(), w = t >> 6, l = t & 63, c = 2 * l;
  bf16_t* mg = WSP(bf16_t, merged); const bf16_t* gm = (const bf16_t*)p.out;
  _Pragma("nounroll") for (int it = 0; it < 128 / NW; ++it) { const int row = it * NW + w; const long tok = m0 + row;
    const unsigned g = *(const unsigned*)(gm + tok * (2 * D_MODEL) + which * D_MODEL + n0 + c);
    float v0 = bflo(g) * st[row * ST_LD + c], v1 = bfhi(g) * st[row * ST_LD + c + 1];
    unsigned* dst = (unsigned*)(mg + tok * D_MODEL + n0 + c);
    if (which == 1) { const unsigned prev = *dst; v0 += bflo(prev); v1 += bfhi(prev); }
    *dst = pack2(v0, v1); }
}
DI void epi_wout(const Params& p, const float* st, int m0, int n0) {
  const int t = tid(), w = t >> 6, l = t & 63, c = 2 * l;
  bf16_t* y = WSP(bf16_t, y);
  _Pragma("nounroll") for (int it = 0; it < 128 / NW; ++it) { const int row = it * NW + w; const long tok = m0 + row;
    *(unsigned*)(y + tok * D_MODEL + n0 + c) = pack2(st[row * ST_LD + c], st[row * ST_LD + c + 1]); }
}
DI void epi_pq(const Params& p, const float* st, int m0, int n0) {
  const int t = tid(), w = t >> 6, l = t & 63, c = 2 * l; bf16_t* q = WSP(bf16_t, qry);
  _Pragma("nounroll") for (int it = 0; it < 128 / NW; ++it) { const int row = it * NW + w; *(unsigned*)(q + (long)(m0 + row) * 2048 + n0 + c) = pack2(st[row * ST_LD + c], st[row * ST_LD + c + 1]); }
}
DI void epi_sc(const Params& p, const float* st, int m0, int n0) {
  const int t = tid(), w = t >> 6, l = t & 63, c = 2 * l; float* sc = WSP(float, sc);
  _Pragma("nounroll") for (int it = 0; it < 128 / NW; ++it) { const int row = it * NW + w; f32x2 v = {st[row * ST_LD + c], st[row * ST_LD + c + 1]}; *(f32x2*)(sc + (long)(m0 + row) * 2048 + n0 + c) = v; }
}

DI u32x2 pack4(const f32x4& v) { return (u32x2){pack2(v[0], v[1]), pack2(v[2], v[3])}; }
DI void epid_store_bf16(bf16_t* base, long ld, int row, int col, const f32x4& v0, const f32x4& v1) {
  bf16_t* dst = base + (long)row * ld + col; *(u32x2*)dst = pack4(v0); *(u32x2*)(dst + 16) = pack4(v1); }
DI void epid_qup(const Params& p, int row, int col, const f32x4& v0, const f32x4& v1, const char* lds) {
  const float rs = ((const float*)(lds + RS_OFF))[row & 255];
  f32x4 a = v0, b = v1;
  if ((col >> 5) % 3 == 2) { const float* rt = WSP(const float, ropeM) + (long)row * 32 + (col & 31); const f32x4 cs = *(const f32x4*)rt, sn = *(const f32x4*)(rt + 16);
    a = v0 * cs - v1 * sn; b = v1 * cs + v0 * sn; }
  epid_store_bf16(WSP(bf16_t, Qm), NH * MQK, row, col, a * rs, b * rs);
}
DI void epid_merge(const Params& p, int row, int col, const f32x4& v0, const f32x4& v1, int which) {
  bf16_t* mg = WSP(bf16_t, merged) + (long)row * D_MODEL + col; const bf16_t* gm = (const bf16_t*)p.out + (long)row * (2 * D_MODEL) + which * D_MODEL + col;
#pragma unroll
  for (int h = 0; h < 2; ++h) { const f32x4& v = h ? v1 : v0; const u32x2 g = *(const u32x2*)(gm + 16 * h);
    f32x4 r = {bflo(g[0]) * v[0], bfhi(g[0]) * v[1], bflo(g[1]) * v[2], bfhi(g[1]) * v[3]};
    if (which == 1) { const u32x2 pr = *(const u32x2*)(mg + 16 * h); r[0] += bflo(pr[0]); r[1] += bfhi(pr[0]); r[2] += bflo(pr[1]); r[3] += bfhi(pr[1]); }
    *(u32x2*)(mg + 16 * h) = pack4(r); } }
DI void epid_proj(const Params& p, int row, int col, const f32x4& v0, const f32x4& v1, int n0) {
  const int nt = n0 >> 7;
  if (nt < 26) {
    const bool isq = nt < 24; const int j = isq ? nt - 20 : nt - 24; const int ld = isq ? QR : KVR;
    epid_store_bf16(isq ? WSP(bf16_t, cq) : WSP(bf16_t, ckv), ld, row, j * 128 + col, v0, v1);
    float sq = v0[0] * v0[0] + v0[1] * v0[1] + v0[2] * v0[2] + v0[3] * v0[3] + v1[0] * v1[0] + v1[1] * v1[1] + v1[2] * v1[2] + v1[3] * v1[3];
    sq += __shfl_xor(sq, 16); sq += __shfl_xor(sq, 32);
    if ((tid() & 63) < 16) (isq ? WSP(float, cqpart) : WSP(float, ckvpart))[(long)(j * 4 + (col >> 5)) * NTOK + row] = sq;
  } else {
    bf16_t* gm = (bf16_t*)p.out + (long)row * (2 * D_MODEL) + (nt - 26) * 128 + col;
    const f32x4 s0 = {fsigmoid(v0[0]), fsigmoid(v0[1]), fsigmoid(v0[2]), fsigmoid(v0[3])}, s1 = {fsigmoid(v1[0]), fsigmoid(v1[1]), fsigmoid(v1[2]), fsigmoid(v1[3])};
    *(u32x2*)gm = pack4(s0); *(u32x2*)(gm + 16) = pack4(s1); }
}
DI void epid_cmp1(const Params& p, int row, int col, const f32x4& v0, const f32x4& v1, int which) {
  const float* bias = WSP(const float, cmpbias) + which * CMP_HIDDEN + col; bf16_t* hid = WSP(bf16_t, hid) + (size_t)which * BATCH * NG * NCP * CMP_HIDDEN + (long)row * CMP_HIDDEN + col;
  const f32x4 b0 = *(const f32x4*)bias, b1 = *(const f32x4*)(bias + 16);
  const f32x4 r0 = {fgelu_tanh(v0[0] + b0[0]), fgelu_tanh(v0[1] + b0[1]), fgelu_tanh(v0[2] + b0[2]), fgelu_tanh(v0[3] + b0[3])}, r1 = {fgelu_tanh(v1[0] + b1[0]), fgelu_tanh(v1[1] + b1[1]), fgelu_tanh(v1[2] + b1[2]), fgelu_tanh(v1[3] + b1[3])};
  *(u32x2*)hid = pack4(r0); *(u32x2*)(hid + 16) = pack4(r1); }

template <int DV> struct FlashAcc { f32x16 o[DV / 32]; float m, l; };
template <int DV> DI void flash_init(FlashAcc<DV>& a) { for (int i = 0; i < DV / 32; ++i) a.o[i] = zero16(); a.m = -1e30f; a.l = 0.f; }

template <int DQK> DI void load_q(bf16x8 (&qf)[DQK / 16], const bf16_t* qrow, int lh) {
#pragma unroll
  for (int kk = 0; kk < DQK / 16; ++kk) qf[kk] = *(const bf16x8*)(qrow + kk * 16 + lh * 8);
}

template <int DQK, int DV, class MaskF>
DI void flash_run(const bf16x8 (&qf)[DQK / 16], const bf16_t* Kp, long ldk, const bf16_t* Vp, const bf16_t* V2p, long ldv, int kt0, int kt1,
                  float scl, MaskF mask, FlashAcc<DV>& A, char* lds) {
  constexpr int KSTR = DQK * 2 + 16, VSTR = 136, KCH = DQK / 8;
  constexpr int KB = 64 * KSTR, VB = DV * VSTR;
  constexpr int NKCH = 64 * KCH, NVCH = DV * 8, NKC = (NKCH + NTHREADS - 1) / NTHREADS, NVC = (NVCH + NTHREADS - 1) / NTHREADS;
  const int t = tid(), l = t & 63, lr = l & 31, lh = l >> 5;
  char* const kb0 = lds; char* const kb1 = lds + KB; char* const vb0 = lds + 2 * KB; char* const vb1 = lds + 2 * KB + VB;
  u32x4 rk[NKC], rv[NVC], rk2[NKC], rv2[NVC];
  auto gload = [&](int kt, u32x4 (&rk_)[NKC], u32x4 (&rv_)[NVC]) __attribute__((always_inline)) { const int ktc = kt < kt1 ? kt : kt1 - 1;
#pragma unroll
    for (int i = 0; i < NKC; ++i) { const int cidx = t + NTHREADS * i, row = cidx / KCH, kc = cidx % KCH; if (NKCH % NTHREADS == 0 || cidx < NKCH) rk_[i] = GLD16(Kp + (long)(ktc * 64 + row) * ldk + kc * 8); }
#pragma unroll
    for (int i = 0; i < NVC; ++i) { const int cidx = t + NTHREADS * i, d = cidx >> 3, kc = cidx & 7; const bf16_t* src = (DV > 64 && d >= 64) ? (V2p + (long)(d - 64) * ldv) : (Vp + (long)d * ldv); if (NVCH % NTHREADS == 0 || cidx < NVCH) rv_[i] = GLD16(src + ktc * 64 + kc * 8); }
  };
  auto lwrite = [&](int buf) __attribute__((always_inline)) { char* const kbw = buf ? kb1 : kb0; char* const vbw = buf ? vb1 : vb0;
#pragma unroll
    for (int i = 0; i < NKC; ++i) { const int cidx = t + NTHREADS * i, row = cidx / KCH, kc = cidx % KCH; if (NKCH % NTHREADS == 0 || cidx < NKCH) *(u32x4*)(kbw + row * KSTR + kc * 16) = rk[i]; }
#pragma unroll
    for (int i = 0; i < NVC; ++i) { const int cidx = t + NTHREADS * i, d = cidx >> 3, kc = cidx & 7; char* dst = vbw + d * VSTR + kc * 16;
      if (NVCH % NTHREADS == 0 || cidx < NVCH) { u32x2 lo = {rv[i][0], rv[i][1]}, hi = {rv[i][2], rv[i][3]}; *(u32x2*)dst = lo; *(u32x2*)(dst + 8) = hi; } }
  };
  if (kt0 >= kt1) return;
  gload(kt0, rk, rv); lwrite(0); gload(kt0 + 1, rk, rv); __syncthreads();
  for (int kt = kt0; kt < kt1; ++kt) {
    const int cur = (kt - kt0) & 1; const bool more = kt + 1 < kt1; const char* const kbc = cur ? kb1 : kb0; const char* const vbc = cur ? vb1 : vb0;
    gload(kt + 2, rk2, rv2);
    if (!mask.dead(kt)) {
    f32x16 s[2];
#pragma unroll
    for (int kbk = 0; kbk < 2; ++kbk) { s[kbk] = zero16();
#pragma unroll
      for (int kk = 0; kk < DQK / 16; ++kk) { bf16x8 a = *(const bf16x8*)(kbc + (kbk * 32 + lr) * KSTR + kk * 32 + lh * 16); s[kbk] = mfma32(a, qf[kk], s[kbk]); } }
    const bool tile_ok = mask.tile(kt);
    float mnew, alpha, rsum = 0.f;
    if (mask.interior(kt)) {
      float mr = -3e38f;
#pragma unroll
      for (int kbk = 0; kbk < 2; ++kbk)
#pragma unroll
        for (int i = 0; i < 16; i += 2) mr = fmaxf(fmaxf(mr, s[kbk][i]), s[kbk][i + 1]);
      mr = fmaxf(mr, __shfl_xor(mr, 32));
      const float sl = tile_ok ? scl : 0.f;
      const float mx = tile_ok ? mr * scl : -1e30f;
      mnew = fmaxf(A.m, mx); alpha = fexp2(A.m - mnew); A.m = mnew;
      const float nb = tile_ok ? -mnew : -2e30f;
#pragma unroll
      for (int kbk = 0; kbk < 2; ++kbk)
#pragma unroll
        for (int i = 0; i < 16; ++i) { const float pv = fexp2(__builtin_fmaf(s[kbk][i], sl, nb)); s[kbk][i] = pv; rsum += pv; }
    } else {
      const int hiL = tile_ok ? mask.hi(kt) : -1, loL = mask.lo(kt);
      float mx = -1e30f;
#pragma unroll
      for (int kbk = 0; kbk < 2; ++kbk)
#pragma unroll
        for (int i = 0; i < 16; ++i) { const int c = kbk * 32 + crow(i, lh); const bool ok = (c <= hiL) & (c > loL); const float v = ok ? s[kbk][i] * scl : -1e30f; s[kbk][i] = v; mx = fmaxf(mx, v); }
      mx = fmaxf(mx, __shfl_xor(mx, 32));
      mnew = fmaxf(A.m, mx); alpha = fexp2(A.m - mnew); A.m = mnew;
      const float msub = (mnew > -1e29f) ? mnew : 1e30f;
#pragma unroll
      for (int kbk = 0; kbk < 2; ++kbk)
#pragma unroll
        for (int i = 0; i < 16; ++i) { const float pv = fexp2(s[kbk][i] - msub); s[kbk][i] = pv; rsum += pv; }
    }
    rsum += __shfl_xor(rsum, 32);
    A.l = A.l * alpha + rsum;
#pragma unroll
    for (int db = 0; db < DV / 32; ++db) A.o[db] = A.o[db] * alpha;
#pragma unroll
    for (int kbk = 0; kbk < 2; ++kbk)
#pragma unroll
      for (int s2 = 0; s2 < 2; ++s2) {
        u32x4 pk; for (int j = 0; j < 4; ++j) pk[j] = pack2(s[kbk][8 * s2 + 2 * j], s[kbk][8 * s2 + 2 * j + 1]);
        const bf16x8 pf = __builtin_bit_cast(bf16x8, pk);
#pragma unroll
        for (int db = 0; db < DV / 32; ++db) {
          const char* vr = vbc + (db * 32 + lr) * VSTR + (kbk * 32 + 16 * s2 + 4 * lh) * 2;
          const u32x2 lo = *(const u32x2*)vr, hi = *(const u32x2*)(vr + 16);
          u32x4 vv = {lo[0], lo[1], hi[0], hi[1]};
          A.o[db] = mfma32(__builtin_bit_cast(bf16x8, vv), pf, A.o[db]);
        }
      }
    }
    if (more) lwrite(cur ^ 1);
#pragma unroll
    for (int i = 0; i < NKC; ++i) rk[i] = rk2[i];
#pragma unroll
    for (int i = 0; i < NVC; ++i) rv[i] = rv2[i];
    __syncthreads();
  }
}

struct MaskNsa { int tq, kmul, kadd, wlim; unsigned long long bits; int tqmin, tqmax;
  DI bool tile(int kt) const { return (bits >> kt) & 1ull; }
  DI bool interior(int kt) const { return ((kt * 64 + 63) * kmul + kadd <= tqmin) && (tqmax - kt * 64 < wlim); }
  DI bool dead(int kt) const { return ((kt * 64) * kmul + kadd > tqmax) || (tqmin - (kt * 64 + 63) >= wlim); }
  DI int hi(int kt) const { const int q = tq - kadd; return (q >= 0 ? q / kmul : -1) - kt * 64; }
  DI int lo(int kt) const { return tq - wlim - kt * 64; }
  DI bool ok(int key) const { return (key * kmul + kadd <= tq) && (tq - key < wlim); } };
struct MaskCausal { int tq, tqmin; DI bool tile(int) const { return true; } DI bool interior(int kt) const { return kt * 64 + 63 <= tqmin; } DI bool dead(int kt) const { return kt * 64 > tqmin + 31; }
  DI int hi(int kt) const { return tq - kt * 64; } DI int lo(int) const { return -(1 << 30); } DI bool ok(int key) const { return key <= tq; } };
#ifdef HOST_EMU
DI char* launder(char* p) { return p; }
#else
DI char* launder(char* p) { asm volatile("" : "+s"(p)); return p; }
#endif
DI void nsa_tile(const Params& pin, int b, int g, int t0, char* lds) {
  Params p = pin; p.ws = launder(p.ws);
  const int t = tid(), w = t >> 6, l = t & 63, lr = l & 31, lh = l >> 5;
  const int qh = w >> 2, hidx = g * 4 + (w & 3), tq = t0 + qh * 32 + lr; const long tok = (long)b * SEQ + tq;
  const float SCL = 0.125f * 1.4426950408889634f;
  bf16x8 qf[4]; load_q<64>(qf, WSP(const bf16_t, Qn) + tok * 1024 + hidx * 64, lh);
  const float* gn = WSP(const float, gn) + tok * 48 + hidx * 3;
  const float g_cmp = gn[0], g_sel = gn[1], g_win = gn[2];
  const long bg = (long)b * NG + g;
  float* imp4 = (float*)lds; float* ofl = (float*)(lds + 65536) + w * 2048 + l; unsigned long long* masks = (unsigned long long*)(lds + LDS_MAIN - 512);
  const int cmp_kt1 = ((t0 + 32) / 16 + 1 + 63) / 64;
  const int diag_kt1 = (t0 + 63) / 64 + 1;
  unsigned long long mymask = ~0ull;
#pragma nounroll
  for (int br = 0; br < 4; ++br) {
    const bf16_t *Kp, *Vp; long ldv; int kt0 = 0, kt1, kmul = 1, kadd = 0, wlim = 1 << 30; unsigned long long bits = ~0ull; float gate;
    if (br <= 1) { Kp = WSP(const bf16_t, Kc) + bg * NCP * 64; Vp = br == 0 ? WSP(const bf16_t, ovlT) : WSP(const bf16_t, VcT) + bg * 64 * NCP; ldv = NCP; kt1 = cmp_kt1; kmul = 16; kadd = 31; gate = g_cmp; }
    else if (br == 2) { Kp = WSP(const bf16_t, Ks) + bg * SEQ * 64; Vp = WSP(const bf16_t, VsT) + bg * 64 * SEQ; ldv = SEQ; kt1 = diag_kt1; bits = mymask; gate = g_sel; }
    else { Kp = WSP(const bf16_t, Kw) + bg * SEQ * 64; Vp = WSP(const bf16_t, VwT) + bg * 64 * SEQ; ldv = SEQ; const int lo = t0 - (WINDOW - 1); kt0 = lo > 0 ? lo / 64 : 0; kt1 = diag_kt1; wlim = WINDOW; gate = g_win; }
    FlashAcc<64> A; flash_init(A);
    flash_run<64, 64>(qf, Kp, 64, Vp, (const bf16_t*)nullptr, ldv, kt0, kt1, SCL, MaskNsa{tq, kmul, kadd, wlim, bits, t0 + qh * 32, t0 + qh * 32 + 31}, A, lds);
    const float inv = A.l > 0.f ? 1.0f / A.l : 0.f;
    if (br == 0) {
#pragma unroll
      for (int db = 0; db < 2; ++db)
#pragma unroll
        for (int i = 0; i < 16; ++i) imp4[(w * 32 + lr) * 64 + db * 32 + crow(i, lh)] = A.o[db][i] * inv;
      __syncthreads();
#pragma nounroll
      for (int qi = 0; qi < 8; ++qi) {
        const int q = w * 8 + qi, tt = t0 + q, tb = tt >> 6;
        const float* ib = imp4 + ((q >> 5) * 4 * 32 + (q & 31)) * 64 + l;
        float v = ib[0] + ib[32 * 64] + ib[2 * 32 * 64] + ib[3 * 32 * 64];
        const bool valid = (l * 64 <= tt) && (l < NSEL);
        const bool forced = (l == 0) || (l == tb) || (l == tb - 1);
        v = valid ? (v + (forced ? 1e4f : 0.f)) : -1e30f;
        const int ki = (int)((f2u(v) & ~63u) | (unsigned)(63 - l));
        int rank = 0;
#pragma unroll
        for (int j = 0; j < 64; ++j) { const int kj = bcast_i(ki, j); rank += (kj > ki) ? 1 : 0; }
        const unsigned long long mk = __ballot(rank < 16);
        if (l == 0) masks[q] = mk;
      }
      __syncthreads();
      mymask = masks[qh * 32 + lr];
      __syncthreads();
    } else {
      const float sc = inv * gate;
      if (br == 1) {
#pragma unroll
        for (int db = 0; db < 2; ++db)
#pragma unroll
          for (int i = 0; i < 16; ++i) ofl[(db * 16 + i) * 64] = A.o[db][i] * sc;
      } else if (br == 2) {
#pragma unroll
        for (int db = 0; db < 2; ++db)
#pragma unroll
          for (int i = 0; i < 16; ++i) ofl[(db * 16 + i) * 64] += A.o[db][i] * sc;
      } else {
        bf16_t* on = WSP(bf16_t, on) + tok * 1024 + hidx * 64;
#pragma unroll
        for (int db = 0; db < 2; ++db)
#pragma unroll
          for (int q4 = 0; q4 < 4; ++q4) { float v[4];
#pragma unroll
            for (int e = 0; e < 4; ++e) v[e] = ofl[(db * 16 + 4 * q4 + e) * 64] + A.o[db][4 * q4 + e] * sc;
            u32x2 pk = {pack2(v[0], v[1]), pack2(v[2], v[3])}; *(u32x2*)(on + db * 32 + 8 * q4 + 4 * lh) = pk; }
      }
    }
  }
}

DI void mla_tile(const Params& pin, int b, int hd, int t0, char* lds) {
  Params p = pin; p.ws = launder(p.ws);
  const int t = tid(), w = t >> 6, l = t & 63, lr = l & 31, lh = l >> 5;
  const int tq = t0 + w * 32 + lr; const long tok = (long)b * SEQ + tq;
  const float SCL = 0.10206207261596575f * 1.4426950408889634f;
  bf16x8 qf[6]; load_q<96>(qf, WSP(const bf16_t, Qm) + tok * (NH * MQK) + hd * MQK, lh);
  FlashAcc<64> A; flash_init(A);
  const long bh = (long)b * NH + hd;
  flash_run<96, 64>(qf, WSP(const bf16_t, Km) + bh * SEQ * MQK, MQK, WSP(const bf16_t, VmT) + bh * 64 * SEQ, (const bf16_t*)nullptr, SEQ, 0, (t0 + 255) / 64 + 1, SCL, MaskCausal{tq, t0 + w * 32}, A, lds);
  const float inv = A.l > 0.f ? 1.0f / A.l : 0.f;
  bf16_t* om = WSP(bf16_t, om) + tok * 1024 + hd * 64;
#pragma unroll
  for (int db = 0; db < 2; ++db)
#pragma unroll
    for (int q4 = 0; q4 < 4; ++q4) { u32x2 v = {pack2(A.o[db][4 * q4] * inv, A.o[db][4 * q4 + 1] * inv), pack2(A.o[db][4 * q4 + 2] * inv, A.o[db][4 * q4 + 3] * inv)}; *(u32x2*)(om + db * 32 + 8 * q4 + 4 * lh) = v; }
}

DI int proj_colmap(int j) {
  if (j < 2560) return j;
  if (j < PC_CKV) return 2608 + (j - PC_CQ);
  if (j < PC_GM) return 3120 + (j - PC_CKV);
  if (j < PC_KR) return 3408 + (j - PC_GM);
  if (j < PC_GN) return 3376 + (j - PC_KR);
  if (j < PC_GN + 48) return 2560 + (j - PC_GN);
  return -1;
}
constexpr int CVN = 4096 / NTHREADS;
DI void convT_load(const float* src, int N, const float* scale, bool projmap, int kt, int nt, float (&v)[CVN]) {
  const int t = tid();
#pragma unroll
  for (int i = 0; i < CVN; ++i) { const int idx = i * NTHREADS + t, kr = idx >> 6, nc = idx & 63; const int n = nt * 64 + nc; const int col = projmap ? proj_colmap(n) : (n < N ? n : -1);
    float x = 0.f; if (col >= 0) { x = __builtin_nontemporal_load(src + (long)(kt * 64 + kr) * N + col); if (scale) x *= scale[kt * 64 + kr]; }
    v[i] = x; }
}
DI void convT_store(int K, bf16_t* dst, int kt, int nt, const float (&v)[CVN], char* lds) {
  float* tile = (float*)lds; const int t = tid();
  __syncthreads();
#pragma unroll
  for (int i = 0; i < CVN; ++i) { const int idx = i * NTHREADS + t, kr = idx >> 6, nc = idx & 63; tile[kr * 65 + nc] = v[i]; }
  __syncthreads();
#pragma unroll
  for (int i = 0; i < 2048 / NTHREADS; ++i) { const int idx = i * NTHREADS + t, n = idx >> 5, kp = idx & 31;
    *(unsigned*)(dst + (long)(nt * 64 + n) * K + kt * 64 + 2 * kp) = pack2(tile[(2 * kp) * 65 + n], tile[(2 * kp + 1) * 65 + n]); }
}
constexpr int CWN = 1024 / NTHREADS;
DI void convW_load(const float* src, int N, bool projmap, int kt, int nt4, f32x4 (&v)[4][CWN]) {
  const int t = tid();
#pragma unroll
  for (int j = 0; j < 4; ++j)
#pragma unroll
    for (int i = 0; i < CWN; ++i) { const int idx = i * NTHREADS + t, kr = idx >> 4, n4 = (idx & 15) * 4; const int n = (nt4 * 4 + j) * 64 + n4;
      f32x4 x = {0.f, 0.f, 0.f, 0.f};
      const int c0 = projmap ? proj_colmap(n) : (n < N ? n : -1), c3 = projmap ? proj_colmap(n + 3) : (n + 3 < N ? n + 3 : -1);
      const float* rowp = src + (long)(kt * 64 + kr) * N;
      if (c0 >= 0 && c3 == c0 + 3 && ((c0 & 3) == 0) && ((N & 3) == 0)) x = __builtin_nontemporal_load((const f32x4*)(rowp + c0));
      else { for (int e = 0; e < 4; ++e) { const int c = projmap ? proj_colmap(n + e) : (n + e < N ? n + e : -1); if (c >= 0) x[e] = rowp[c]; } }
      v[j][i] = x; }
}
DI void convW_store(int K, bf16_t* dst, int kt, int nt4, const f32x4 (&v)[4][CWN], char* lds) {
  float* tile = (float*)lds; const int t = tid();
  __syncthreads();
#pragma unroll
  for (int j = 0; j < 4; ++j)
#pragma unroll
    for (int i = 0; i < CWN; ++i) { const int idx = i * NTHREADS + t, kr = idx >> 4, n4 = (idx & 15) * 4;
#pragma unroll
      for (int e = 0; e < 4; ++e) tile[j * 4160 + kr * 65 + n4 + e] = v[j][i][e]; }
  __syncthreads();
#pragma unroll
  for (int j = 0; j < 4; ++j)
#pragma unroll
    for (int i = 0; i < 2048 / NTHREADS; ++i) { const int idx = i * NTHREADS + t, n = idx >> 5, kp = idx & 31;
      *(unsigned*)(dst + (long)((nt4 * 4 + j) * 64 + n) * K + kt * 64 + 2 * kp) = pack2(tile[j * 4160 + (2 * kp) * 65 + n], tile[j * 4160 + (2 * kp + 1) * 65 + n]); }
}
constexpr int TAB_TPR = D_MODEL / 8, TAB_RPP = NTHREADS / TAB_TPR, TAB_WPR = TAB_TPR >= 64 ? TAB_TPR / 64 : 1;
constexpr int TAB_N = NEXP / (4 * TAB_RPP);
DI void tab_items(const Params& p, char* lds, int first, int stride, int end) {
  const int t = tid(); float* red = (float*)lds;
  f32x4 a[4], bq[4], na[4], nb[4];
  auto tload = [&](int it_, f32x4 (&x)[4], f32x4 (&y)[4]) __attribute__((always_inline)) { const int ic = it_ < end ? it_ : first; const float* src = ic < TAB_N ? p.peer_u : p.peer_v; const int il = ic < TAB_N ? ic : ic - TAB_N;
#pragma unroll
    for (int u = 0; u < 4; ++u) { const long base = ((long)il * 4 + u) * (TAB_RPP * D_MODEL) + t * 8; x[u] = __builtin_nontemporal_load((const f32x4*)(src + base)); y[u] = __builtin_nontemporal_load((const f32x4*)(src + base + 4)); } };
  if (first < end) tload(first, a, bq);
  for (int item = first; item < end; item += stride) { tload(item + stride, na, nb);
    const bool isu = item < TAB_N; const int il = isu ? item : item - TAB_N;
    unsigned char* dst = isu ? WSP(unsigned char, U16) : WSP(unsigned char, V16); float* inv = isu ? WSP(float, uinv) : WSP(float, vinv);
    float mx[4];
#pragma unroll
    for (int u = 0; u < 4; ++u) { float m = 0.f;
#pragma unroll
      for (int e = 0; e < 4; ++e) m = fmaxf(m, fmaxf(fabsf(a[u][e]), fabsf(bq[u][e])));
      for (int sft = 32; sft >= 1; sft >>= 1) m = fmaxf(m, __shfl_xor(m, sft));
      mx[u] = m; }
    if (TAB_WPR > 1) { __syncthreads(); if ((t & 63) == 0) { for (int u = 0; u < 4; ++u) red[(t >> 6) * 4 + u] = mx[u]; } __syncthreads();
#pragma unroll
      for (int u = 0; u < 4; ++u) { float m = 0.f; const int w0 = (t / TAB_TPR) * TAB_WPR; for (int ww = 0; ww < TAB_WPR; ++ww) m = fmaxf(m, red[(w0 + ww) * 4 + u]); mx[u] = m; } }
#pragma unroll
    for (int u = 0; u < 4; ++u) { const long e = ((long)il * 4 + u) * TAB_RPP + t / TAB_TPR; const int col = (t % TAB_TPR) * 8; const float m = mx[u] > 0.f ? mx[u] : 1.f; const float sc = 440.0f / m;
      u32x2 o = {enc_fp8x4(a[u][0] * sc, a[u][1] * sc, a[u][2] * sc, a[u][3] * sc), enc_fp8x4(bq[u][0] * sc, bq[u][1] * sc, bq[u][2] * sc, bq[u][3] * sc)};
      *(u32x2*)(dst + ((long)(col >> 7) * NEXP + e) * 128 + (col & 127)) = o;
      if ((t % TAB_TPR) == 0) inv[e] = m * (1.0f / 440.0f); }
#pragma unroll
    for (int u = 0; u < 4; ++u) { a[u] = na[u]; bq[u] = nb[u]; } }
}
constexpr int LC_N0 = (1024 / 64) * (D_MODEL / 256), LC_N2 = (D_MODEL / 64) * (D_MODEL / 256), LC_N3 = (D_MODEL / 64) * (2048 / 256), LC_TOTAL = 2 * LC_N0 + LC_N2 + LC_N3;
DI void late_conv_items(const Params& p, char* lds, int first, int stride, int end) {
  auto job = [&](int it, const float*& src, int& K, int& N, bf16_t*& dst, int& kt, int& nt4) __attribute__((always_inline)) {
    int r = it;
    if (r < LC_N0) { src = p.w_branch_nsa; K = 1024; N = D_MODEL; dst = WSP(bf16_t, WnT); }
    else if ((r -= LC_N0) < LC_N0) { src = p.w_branch_mla; K = 1024; N = D_MODEL; dst = WSP(bf16_t, WmT); }
    else if ((r -= LC_N0) < LC_N2) { src = p.w_out; K = D_MODEL; N = D_MODEL; dst = WSP(bf16_t, WoT); }
    else { r -= LC_N2; src = p.peer_w_q; K = D_MODEL; N = 2048; dst = WSP(bf16_t, WpqT); }
    const int nkt = K / 64; kt = r % nkt; nt4 = r / nkt; };
  f32x4 cv[4][CWN], nv[4][CWN]; const float* src; int K, N, kt, nt4; bf16_t* dst;
  if (first < end) { job(first, src, K, N, dst, kt, nt4); convW_load(src, N, false, kt, nt4, cv); }
  for (int item = first; item < end; item += stride) { const int nx = item + stride < end ? item + stride : item;
    const float* s2; int K2, N2, kt2, nt2; bf16_t* d2; job(nx, s2, K2, N2, d2, kt2, nt2); convW_load(s2, N2, false, kt2, nt2, nv);
    job(item, src, K, N, dst, kt, nt4); convW_store(K, dst, kt, nt4, cv, lds);
#pragma unroll
    for (int j = 0; j < 4; ++j)
#pragma unroll
      for (int i = 0; i < CWN; ++i) cv[j][i] = nv[j][i]; }
}

DI void phase0(const Params& p, char* lds) {
  const int t = tid();
  int item = blockIdx.x;
  constexpr int N_ADA = 6 * D_MODEL / 64;
  for (; item < N_ADA; item += gridDim.x) {
    float* sc = (float*)lds;
    __syncthreads();
    for (int i = t; i < BATCH * D_MODEL; i += NTHREADS) { const float v = p.c[i]; sc[i] = v * fsigmoid(v); }
    __syncthreads();
    const int w = t >> 6, l = t & 63, cqd = l & 15, rs = l >> 4; const int n0 = item * 64 + cqd * 4;
    f32x4 acc[BATCH]; for (int b = 0; b < BATCH; ++b) acc[b] = (f32x4){0.f, 0.f, 0.f, 0.f};
    for (int j0 = 0; j0 < D_MODEL / (4 * NW); j0 += 8) { f32x4 wv[8];
#pragma unroll
      for (int u = 0; u < 8; ++u) { const int k = (j0 + u) * (4 * NW) + w * 4 + rs; wv[u] = __builtin_nontemporal_load((const f32x4*)(p.ada_w + (long)k * (6 * D_MODEL) + n0)); }
#pragma unroll
      for (int u = 0; u < 8; ++u) { const int k = (j0 + u) * (4 * NW) + w * 4 + rs;
#pragma unroll
        for (int b = 0; b < BATCH; ++b) acc[b] += wv[u] * sc[b * D_MODEL + k]; } }
    float* red = (float*)(lds + BATCH * D_MODEL * 4);
    for (int b = 0; b < BATCH; ++b) for (int e = 0; e < 4; ++e) { float v = acc[b][e]; v += __shfl_xor(v, 16); v += __shfl_xor(v, 32); if (rs == 0) red[(w * BATCH + b) * 64 + cqd * 4 + e] = v; }
    __syncthreads();
    if (t < 64 * BATCH) { const int b = t >> 6, cc = t & 63; float v = 0.f; for (int ww = 0; ww < NW; ++ww) v += red[(ww * BATCH + b) * 64 + cc];
      WSP(float, mod)[(long)b * 6 * D_MODEL + item * 64 + cc] = v + p.ada_b[item * 64 + cc]; }
  }
  item -= N_ADA;
  auto convjob = [&](const float* src, int K, int N, int Npad, bf16_t* dst, const float* scale, bool projmap) __attribute__((always_inline)) {
    const int nkt = K / 64, nnt = Npad / 64, n = nkt * nnt;
    float cv[CVN], nv[CVN];
    if (item < n) convT_load(src, N, scale, projmap, item % nkt, item / nkt, cv);
    for (; item < n; item += gridDim.x) { const int nx = item + (int)gridDim.x < n ? item + (int)gridDim.x : item;
      convT_load(src, N, scale, projmap, nx % nkt, nx / nkt, nv);
      convT_store(K, dst, item % nkt, item / nkt, cv, lds);
#pragma unroll
      for (int i = 0; i < CVN; ++i) cv[i] = nv[i]; }
    item -= n; };
  { const int nkt = D_MODEL / 64, n = nkt * (NPROJ / 256); f32x4 cv[4][CWN], nv[4][CWN];
    if (item < n) convW_load(p.w_in, IN_COLS, true, item % nkt, item / nkt, cv);
    for (; item < n; item += gridDim.x) { const int nx = item + (int)gridDim.x < n ? item + (int)gridDim.x : item;
      convW_load(p.w_in, IN_COLS, true, nx % nkt, nx / nkt, nv);
      convW_store(D_MODEL, WSP(bf16_t, WinT), item % nkt, item / nkt, cv, lds);
#pragma unroll
      for (int j = 0; j < 4; ++j)
#pragma unroll
        for (int i = 0; i < CWN; ++i) cv[j][i] = nv[j][i]; }
    item -= n; }
  convjob(p.cmp_w1, 2048, CMP_HIDDEN, CMP_HIDDEN, WSP(bf16_t, W1T), nullptr, false);
  convjob(p.cmp_w1 + (size_t)2048 * CMP_HIDDEN, 2048, CMP_HIDDEN, CMP_HIDDEN, WSP(bf16_t, W1T) + (size_t)CMP_HIDDEN * 2048, nullptr, false);
  convjob(p.cmp_w2, CMP_HIDDEN, 64, 128, WSP(bf16_t, W2T), nullptr, false);
  convjob(p.cmp_w2 + CMP_HIDDEN * 64, CMP_HIDDEN, 64, 128, WSP(bf16_t, W2T) + 128 * CMP_HIDDEN, nullptr, false);
  convjob(p.mla_w_q_up, QR, NH * MQK, NH * MQK, WSP(bf16_t, WquT), p.mla_q_norm_g, false);
  convjob(p.mla_w_kv_up, KVR, NH * 128, NH * 128, WSP(bf16_t, WkvT), p.mla_kv_norm_g, false);
  auto cvtjob = [&](const float* src, bf16_t* dst, long cnt) __attribute__((always_inline)) {
    const int n = (int)(cnt / (NTHREADS * 8));
    for (; item < n; item += gridDim.x) { const long base = (long)item * (NTHREADS * 8) + t * 8; const f32x4 a = *(const f32x4*)(src + base), bq = *(const f32x4*)(src + base + 4);
      u32x4 o = {pack2(a[0], a[1]), pack2(a[2], a[3]), pack2(bq[0], bq[1]), pack2(bq[2], bq[3])}; *(u32x4*)(dst + base) = o; }
    item -= n; };
  cvtjob(p.peer_sub_keys, WSP(bf16_t, SK), 16 * 128 * 128);
  { const int n = (NTOK + NTHREADS - 1) / NTHREADS;
    for (; item < n; item += gridDim.x) { const int tok = item * NTHREADS + t; if (tok < NTOK) { const float pf = (float)p.pos[tok];
        float* rn = WSP(float, ropeN) + (long)tok * 16; float* rm = WSP(float, ropeM) + (long)tok * 32;
        for (int i = 0; i < 8; ++i) { const float inv = fexp2(-(float)i * (2.0f / 16.0f) * 18.931568569324174f); const float ang = pf * inv; double r = (double)ang * 0.15915494309189535; r -= __builtin_rint(r); rn[i] = fcos_rev((float)r); rn[8 + i] = fsin_rev((float)r); }
        for (int i = 0; i < 16; ++i) { const float inv = fexp2(-(float)i * (2.0f / 32.0f) * 18.931568569324174f); const float ang = pf * inv; double r = (double)ang * 0.15915494309189535; r -= __builtin_rint(r); rm[i] = fcos_rev((float)r); rm[16 + i] = fsin_rev((float)r); } } }
    item -= n; }
  { const int n = 8;
    for (; item < n; item += gridDim.x) { const int which = item >> 2, j0 = (item & 3) * 64; const int w = t >> 6, l = t & 63;
      const float* pe = p.cmp_pe + which * 2048; const float* w1 = p.cmp_w1 + (size_t)which * 2048 * CMP_HIDDEN;
      float s = 0.f; for (int k = w; k < 2048; k += NW) s += pe[k] * w1[(long)k * CMP_HIDDEN + j0 + l];
      float* red = (float*)lds; __syncthreads(); red[w * 64 + l] = s; __syncthreads();
      if (t < 64) { float v = p.cmp_b1[which * CMP_HIDDEN + j0 + t]; for (int ww = 0; ww < NW; ++ww) v += red[ww * 64 + t]; WSP(float, cmpbias)[which * CMP_HIDDEN + j0 + t] = v; } }
    item -= n; }
  { const int n = 1;
    for (; item < n; item += gridDim.x) { bf16_t* o = WSP(bf16_t, ovlT); for (int i = t; i < 64 * NCP + 2048; i += NTHREADS) { const int s = i / NCP, nn = i % NCP; o[i] = (s < 64 && nn >= 4 * s - 1 && nn <= 4 * s + 3) ? (bf16_t)0x3f80 : (bf16_t)0; } }
    item -= n; }
}

constexpr int RV = D_MODEL / 256;
DI void phase_prenorm(const Params& p) {
  const int t_ = tid(); const int w = t_ >> 6, l = t_ & 63; const float* mod = WSP(const float, mod); bf16_t* h = WSP(bf16_t, h);
  for (long row = (long)blockIdx.x * NW + w; row < NTOK; row += (long)gridDim.x * NW) { const int b = (int)(row / SEQ);
    f32x4 xv[RV]; float ss = 0.f;
    for (int i = 0; i < RV; ++i) { xv[i] = *(const f32x4*)(p.x + row * D_MODEL + (i * 64 + l) * 4); ss += xv[i][0] * xv[i][0] + xv[i][1] * xv[i][1] + xv[i][2] * xv[i][2] + xv[i][3] * xv[i][3]; }
    const float rs = frsq(wave_sum(ss) / (float)D_MODEL + NORM_EPS);
    for (int i = 0; i < RV; ++i) { const int c0 = (i * 64 + l) * 4; const f32x4 g = *(const f32x4*)(p.attn_pre_g + c0), sh = *(const f32x4*)(mod + (long)b * 6 * D_MODEL + c0), sc = *(const f32x4*)(mod + (long)b * 6 * D_MODEL + D_MODEL + c0);
      f32x4 v = xv[i] * rs * g * (sc + 1.0f) + sh; u32x2 o = {pack2(v[0], v[1]), pack2(v[2], v[3])}; *(u32x2*)(h + row * D_MODEL + c0) = o; } }
}
DI void phase_postattn(const Params& p) {
  const int t_ = tid(); const int w = t_ >> 6, l = t_ & 63; const float* mod = WSP(const float, mod); bf16_t* h2 = WSP(bf16_t, h2); const bf16_t* y = WSP(const bf16_t, y);
  for (long row = (long)blockIdx.x * NW + w; row < NTOK; row += (long)gridDim.x * NW) { const int b = (int)(row / SEQ); const float* mb = mod + (long)b * 6 * D_MODEL;
    f32x4 xv[RV], yq[RV]; float ss = 0.f, sy = 0.f;
#pragma unroll
    for (int i = 0; i < RV; ++i) { const int c0 = (i * 64 + l) * 4; const u32x2 yy = *(const u32x2*)(y + row * D_MODEL + c0); yq[i] = (f32x4){bflo(yy[0]), bfhi(yy[0]), bflo(yy[1]), bfhi(yy[1])};
      sy += yq[i][0] * yq[i][0] + yq[i][1] * yq[i][1] + yq[i][2] * yq[i][2] + yq[i][3] * yq[i][3]; }
    const float rsy = frsq(wave_sum(sy) / (float)D_MODEL + NORM_EPS);
#pragma unroll
    for (int i = 0; i < RV; ++i) { const int c0 = (i * 64 + l) * 4; const f32x4 yv = yq[i];
      const f32x4 g = *(const f32x4*)(p.attn_post_g + c0), ga = *(const f32x4*)(mb + 2 * D_MODEL + c0);
      xv[i] = *(const f32x4*)(p.x + row * D_MODEL + c0) + ga * (yv * rsy * g);
      *(f32x4*)(p.out + row * D_MODEL + c0) = xv[i];
      ss += xv[i][0] * xv[i][0] + xv[i][1] * xv[i][1] + xv[i][2] * xv[i][2] + xv[i][3] * xv[i][3]; }
    const float rs = frsq(wave_sum(ss) / (float)D_MODEL + NORM_EPS);
    for (int i = 0; i < RV; ++i) { const int c0 = (i * 64 + l) * 4; const f32x4 g = *(const f32x4*)(p.ffn_pre_g + c0), sh = *(const f32x4*)(mb + 3 * D_MODEL + c0), sc = *(const f32x4*)(mb + 4 * D_MODEL + c0);
      f32x4 v = xv[i] * rs * g * (sc + 1.0f) + sh; u32x2 o = {pack2(v[0], v[1]), pack2(v[2], v[3])}; *(u32x2*)(h2 + row * D_MODEL + c0) = o; } }
}

DI int okey(float v) { int k = (int)f2u(v); return k ^ ((k >> 31) & 0x7fffffff); }
#ifdef HOST_EMU
DI int permute_push(int dst_lane, int v) { return emu_ds_permute(dst_lane, v); }
#else
DI int permute_push(int dst_lane, int v) { return __builtin_amdgcn_ds_permute(dst_lane << 2, v); }
#endif
#ifdef HOST_EMU
DI int lanes_below(unsigned long long m) { return __builtin_popcountll(m & ((1ull << (tid() & 63)) - 1ull)); }
#else
DI int lanes_below(unsigned long long m) { return (int)__builtin_amdgcn_mbcnt_hi((unsigned)(m >> 32), __builtin_amdgcn_mbcnt_lo((unsigned)m, 0u)); }
#endif
DI void phase_peer_topk(const Params& p) {
  const int t_ = tid(); const int w = t_ >> 6, l = t_ & 63; const float* sc = WSP(const float, sc); unsigned* picks = WSP(unsigned, picks);
  int ci, cj;
  if (l < 16) { ci = 0; cj = l; } else if (l < 24) { ci = 1; cj = l - 16; } else if (l < 29) { ci = 2; cj = l - 24; } else if (l < 33) { ci = 3; cj = l - 29; }
  else if (l < 36) { ci = 4; cj = l - 33; } else if (l < 42) { ci = 5 + ((l - 36) >> 1); cj = (l - 36) & 1; } else { ci = 8 + (l - 42); cj = 0; }
  const bool cvalid = l < 50; if (!cvalid) { ci = 0; cj = 0; }
  for (long it = (long)blockIdx.x * NW + w; it < (long)NTOK * PH; it += (long)gridDim.x * NW) { const long tok = it / PH; const int hh = (int)(it % PH);
    float sv[2]; int si[2];
    float a0[2], a1[2]; int k0[2], k1[2]; unsigned u0[2], u1[2], T[2];
#pragma unroll
    for (int pp = 0; pp < 2; ++pp) { const float* s = sc + tok * 2048 + (hh * 2 + pp) * 128; a0[pp] = s[l]; a1[pp] = s[l + 64];
      k0[pp] = (okey(a0[pp]) & ~127) | (127 - l); k1[pp] = (okey(a1[pp]) & ~127) | (63 - l);
      u0[pp] = (unsigned)k0[pp] ^ 0x80000000u; u1[pp] = (unsigned)k1[pp] ^ 0x80000000u; T[pp] = 0u; }
#pragma unroll
    for (int bit = 31; bit >= 0; --bit) {
#pragma unroll
      for (int pp = 0; pp < 2; ++pp) { const unsigned cand = T[pp] | (1u << bit);
        const int cnt = __builtin_popcountll(__ballot(u0[pp] >= cand)) + __builtin_popcountll(__ballot(u1[pp] >= cand)); if (cnt >= 16) T[pp] = cand; } }
    int kq[2], vq[2], iq[2];
#pragma unroll
    for (int pp = 0; pp < 2; ++pp) {
      const bool s0 = u0[pp] >= T[pp], s1 = u1[pp] >= T[pp]; const unsigned long long m0 = __ballot(s0), m1 = __ballot(s1);
      const int c0 = s0 ? lanes_below(m0) : 63, c1 = s1 ? __builtin_popcountll(m0) + lanes_below(m1) : 63;
      kq[pp] = permute_push(c0, k0[pp]) | permute_push(c1, k1[pp]);
      vq[pp] = permute_push(c0, (int)f2u(a0[pp])) | permute_push(c1, (int)f2u(a1[pp]));
      iq[pp] = permute_push(c0, l) | permute_push(c1, l + 64); }
    int rk[2] = {0, 0};
#pragma unroll
    for (int j = 0; j < 16; ++j) { const int q0 = bcast_i(kq[0], j), q1 = bcast_i(kq[1], j); rk[0] += (q0 > kq[0]); rk[1] += (q1 > kq[1]); }
#pragma unroll
    for (int pp = 0; pp < 2; ++pp) { const int dq = l < 16 ? rk[pp] : 63; sv[pp] = u2f((unsigned)permute_push(dq, vq[pp])); si[pp] = permute_push(dq, iq[pp]); }
    const float cand = shfl_f(sv[0], ci) + shfl_f(sv[1], cj); const int flat = ci * 16 + cj;
    const int kc = cvalid ? ((okey(cand) & ~255) | (255 - flat)) : (int)0x80000000;
    int rc = 0;
#pragma unroll
    for (int j = 0; j < 64; ++j) { const int q = bcast_i(kc, j); rc += (q > kc); }
    const int dc = (cvalid && rc < 16) ? rc : 63;
    const float tv = u2f((unsigned)permute_push(dc, (int)f2u(cand))); const int tp = permute_push(dc, flat);
    const int e1 = shfl_i(si[0], (tp >> 4) & 15), e2 = shfl_i(si[1], tp & 15);
    const float mx = bcast_f(tv, 0); float e = (l < 16) ? fexp2((tv - mx) * 1.4426950408889634f) : 0.f;
    float sum = e; for (int m = 8; m >= 1; m >>= 1) sum += __shfl_xor(sum, m);
    if (l < 16) { unsigned* dst = picks + (tok * NPICK + hh * 16 + l) * 2; dst[0] = (unsigned)(e1 * PNK + e2); dst[1] = f2u(e / sum); } }
}

#ifdef HOST_EMU
#define PIN_ORDER(acc, nxt) do {} while (0)
#else
#define PIN_ORDER(acc, nxt) asm volatile("" : "+v"(acc), "+v"((nxt)[0]), "+v"((nxt)[1]), "+v"((nxt)[2]), "+v"((nxt)[3]))
#endif
#ifdef HOST_EMU
DI float xch1(float x) { return __shfl_xor(x, 1); }
DI float xch2(float x) { return __shfl_xor(x, 2); }
DI float xch7(float x) { return __shfl(x, (tid() & 63) ^ 7); }
DI float xch8(float x) { return __shfl_xor(x, 8); }
DI float xch16(float x) { return __shfl_xor(x, 16); }
DI float xch32(float x) { return __shfl_xor(x, 32); }
#else
DI float xch1(float x) { return u2f((unsigned)__builtin_amdgcn_update_dpp(0, (int)f2u(x), 0xB1, 0xF, 0xF, true)); }
DI float xch2(float x) { return u2f((unsigned)__builtin_amdgcn_update_dpp(0, (int)f2u(x), 0x4E, 0xF, 0xF, true)); }
DI float xch7(float x) { return u2f((unsigned)__builtin_amdgcn_update_dpp(0, (int)f2u(x), 0x141, 0xF, 0xF, true)); }
DI float xch8(float x) { return u2f((unsigned)__builtin_amdgcn_update_dpp(0, (int)f2u(x), 0x128, 0xF, 0xF, true)); }
DI float xch16(float x) { const u32x2 r = __builtin_amdgcn_permlane16_swap(f2u(x), f2u(x), false, false); return u2f((tid() & 16) ? r[0] : r[1]); }
DI float xch32(float x) { const u32x2 r = __builtin_amdgcn_permlane32_swap(f2u(x), f2u(x), false, false); return u2f((tid() & 32) ? r[0] : r[1]); }
#endif
constexpr int NSL = D_MODEL / 128;
struct SliceSched { int g, ngroups, bi, nb; };
DI SliceSched slice_sched() { SliceSched s; const int G = gridDim.x; s.ngroups = G < 8 ? G : 8; s.g = blockIdx.x % s.ngroups; s.bi = blockIdx.x / s.ngroups; s.nb = (G - s.g + s.ngroups - 1) / s.ngroups; return s; }

DI void phase_peer_u(const Params& p) {
  const int t_ = tid(); const int w = t_ >> 6, l = t_ & 63, c8 = l & 7, pg = l >> 3; const SliceSched ss = slice_sched();
  const bf16_t* h2 = WSP(const bf16_t, h2); const unsigned* picks = WSP(const unsigned, picks); bf16_t* apart = WSP(bf16_t, apart);
  const long tstep = (long)ss.nb * NW;
  for (int s = ss.g; s < NSL; s += ss.ngroups) {
    const unsigned char* U = WSP(const unsigned char, U16) + (long)s * NEXP * 128 + c8 * 16;
    auto ldmeta = [&](long tok, u32x2& pk, u32x4& hq0, u32x4& hq1) __attribute__((always_inline)) { const long tc = tok < NTOK ? tok : NTOK - 1;
      { const unsigned* pp = picks + ((unsigned)tc * (unsigned)NPICK + 2u * (unsigned)l) * 2u; pk[0] = pp[0]; pk[1] = pp[2]; } const bf16_t* hp = h2 + ((unsigned)tc * (unsigned)D_MODEL + (unsigned)(s * 128 + c8 * 16)); hq0 = *(const u32x4*)hp; hq1 = *(const u32x4*)(hp + 8); };
    auto issue = [&](const u32x2& pk, u32x4 (&uv)[16]) __attribute__((always_inline)) { const int ipair = (int)((pk[0] & 0xffffu) | (pk[1] << 16));
#pragma unroll
      for (int r2 = 0; r2 < 8; ++r2) { const unsigned pr = (unsigned)shfl_i(ipair, pg * 8 + r2);
        uv[2 * r2] = *(const u32x4*)(U + ((pr & 0xffffu) << 7)); uv[2 * r2 + 1] = *(const u32x4*)(U + ((pr >> 16) << 7)); } };
    auto reduce = [&](long tok, u32x4 (&uv)[16], const u32x4& hq0, const u32x4& hq1) __attribute__((always_inline)) {
      f32x2 hv[8];
#pragma unroll
      for (int q = 0; q < 4; ++q) { hv[q] = (f32x2){bflo(hq0[q]), bfhi(hq0[q])}; hv[4 + q] = (f32x2){bflo(hq1[q]), bfhi(hq1[q])}; }
      float d[16];
#pragma unroll
      for (int r = 0; r < 16; ++r) { f32x2 s2 = {0.f, 0.f};
#pragma unroll
        for (int q = 0; q < 4; ++q) { s2 = __builtin_elementwise_fma(dec_fp8_lo(uv[r][q]), hv[2 * q], s2); s2 = __builtin_elementwise_fma(dec_fp8_hi(uv[r][q]), hv[2 * q + 1], s2); }
        float sacc = s2[0] + s2[1];
        if (r + 1 < 16) PIN_ORDER(sacc, uv[r + 1 < 16 ? r + 1 : 15]);
        d[r] = sacc; }
      float d8[8], d4[4], d2[2];
#pragma unroll
      for (int k = 0; k < 8; ++k) { const bool hi = l & 4; const float keep = hi ? d[8 + k] : d[k], send = hi ? d[k] : d[8 + k]; d8[k] = keep + xch7(send); }
#pragma unroll
      for (int k = 0; k < 4; ++k) { const bool hi = l & 2; const float keep = hi ? d8[4 + k] : d8[k], send = hi ? d8[k] : d8[4 + k]; d4[k] = keep + xch2(send); }
#pragma unroll
      for (int k = 0; k < 2; ++k) { const bool hi = l & 1; const float keep = hi ? d4[2 + k] : d4[k], send = hi ? d4[k] : d4[2 + k]; d2[k] = keep + xch1(send); }
      const int r0 = ((l & 4) ? 8 : 0) + ((l & 2) ? 4 : 0) + ((l & 1) ? 2 : 0);
      if (tok < NTOK) *(unsigned*)(apart + (((unsigned)s * (unsigned)NTOK + (unsigned)tok) * (unsigned)NPICK + (unsigned)(pg * 16 + r0))) = pack2(d2[0], d2[1]); };
    long tok = (long)ss.bi * NW + w;
    u32x2 pkA, pkB; u32x4 hA0, hA1, hB0, hB1, uvA[16], uvB[16];
    ldmeta(tok, pkA, hA0, hA1); issue(pkA, uvA); ldmeta(tok + tstep, pkB, hB0, hB1);
    for (; tok < NTOK; tok += 2 * tstep) {
      u32x2 pkC; u32x4 hC0, hC1;
      issue(pkB, uvB); ldmeta(tok + 2 * tstep, pkC, hC0, hC1);
      reduce(tok, uvA, hA0, hA1);
      issue(pkC, uvA); ldmeta(tok + 3 * tstep, pkB, hA0, hA1);
      reduce(tok + tstep, uvB, hB0, hB1);
      const u32x4 t0 = hA0, t1 = hA1; hA0 = hC0; hA1 = hC1; hB0 = t0; hB1 = t1;
    }
  }
}
DI void phase_peer_w(const Params& p) {
  const unsigned* picks = WSP(const unsigned, picks); const bf16_t* apart = WSP(const bf16_t, apart); unsigned* pw = WSP(unsigned, pw);
  const float* uinv = WSP(const float, uinv); const float* vinv = WSP(const float, vinv);
  for (long i = (long)blockIdx.x * NTHREADS + tid(); i < (long)NTOK * NPICK; i += (long)gridDim.x * NTHREADS) {
    float a = 0.f;
#pragma unroll 8
    for (int s = 0; s < NSL; ++s) a += bf2f(apart[(long)s * NTOK * NPICK + i]);
    const unsigned idx = picks[i * 2]; const float gate = u2f(picks[i * 2 + 1]);
    a *= uinv[idx];
    pw[i] = (idx & 0xffffu) | (pack2(0.f, fgelu_tanh(a) * gate * vinv[idx]) & 0xffff0000u);
  }
}
DI void phase_peer_v(const Params& p) {
  const int t_ = tid(); const int w = t_ >> 6, l = t_ & 63, c8 = l & 7, pg = l >> 3; const SliceSched ss = slice_sched();
  const unsigned* pw = WSP(const unsigned, pw); bf16_t* yb = WSP(bf16_t, yb); float* ypart2 = WSP(float, ypart2);
  const long tstep = (long)ss.nb * NW;
  for (int s = ss.g; s < NSL; s += ss.ngroups) {
    const unsigned char* V = WSP(const unsigned char, V16) + (long)s * NEXP * 128 + c8 * 16;
    auto ldmeta = [&](long tok, u32x2& pq) __attribute__((always_inline)) { const unsigned tc = (unsigned)(tok < NTOK ? tok : NTOK - 1); pq = *(const u32x2*)(pw + (tc * (unsigned)NPICK + 2u * (unsigned)l)); };
    auto issue_half = [&](const u32x2& pq, int half, u32x4 (&vv)[8], unsigned (&wg)[4]) __attribute__((always_inline)) { const int p0 = (int)pq[0], p1 = (int)pq[1];
#pragma unroll
      for (int q = 0; q < 4; ++q) { const int r2 = half * 4 + q; const unsigned re = (unsigned)shfl_i(p0, pg * 8 + r2), ro = (unsigned)shfl_i(p1, pg * 8 + r2); wg[q] = (re >> 16) | (ro & 0xffff0000u);
        vv[2 * q] = *(const u32x4*)(V + ((re & 0xffffu) << 7)); vv[2 * q + 1] = *(const u32x4*)(V + ((ro & 0xffffu) << 7)); } };
    auto acc_half = [&](u32x4 (&vv)[8], unsigned (&wg)[4], f32x2 (&acc)[8]) __attribute__((always_inline)) {
#pragma unroll
      for (int r = 0; r < 8; ++r) { const float wr_ = (r & 1) ? bfhi(wg[r >> 1]) : bflo(wg[r >> 1]); const f32x2 w2 = {wr_, wr_};
#pragma unroll
        for (int q = 0; q < 4; ++q) { acc[2 * q] = __builtin_elementwise_fma(dec_fp8_lo(vv[r][q]), w2, acc[2 * q]); acc[2 * q + 1] = __builtin_elementwise_fma(dec_fp8_hi(vv[r][q]), w2, acc[2 * q + 1]); }
        if (r + 1 < 8) PIN_ORDER(acc[0], vv[r + 1 < 8 ? r + 1 : 7]); } };
    auto finish = [&](long tok, f32x2 (&acc2)[8]) __attribute__((always_inline)) { float acc[16];
#pragma unroll
      for (int j = 0; j < 8; ++j) { acc[2 * j] = acc2[j][0]; acc[2 * j + 1] = acc2[j][1]; }
      float a8[8], a4[4], a2[2];
#pragma unroll
      for (int k = 0; k < 8; ++k) { const bool hi = l & 32; const float keep = hi ? acc[8 + k] : acc[k], send = hi ? acc[k] : acc[8 + k]; a8[k] = keep + xch32(send); }
#pragma unroll
      for (int k = 0; k < 4; ++k) { const bool hi = l & 16; const float keep = hi ? a8[4 + k] : a8[k], send = hi ? a8[k] : a8[4 + k]; a4[k] = keep + xch16(send); }
#pragma unroll
      for (int k = 0; k < 2; ++k) { const bool hi = l & 8; const float keep = hi ? a4[2 + k] : a4[k], send = hi ? a4[k] : a4[2 + k]; a2[k] = keep + xch8(send); }
      const int col = c8 * 16 + ((l & 32) ? 8 : 0) + ((l & 16) ? 4 : 0) + ((l & 8) ? 2 : 0);
      const float sq = wave_sum(a2[0] * a2[0] + a2[1] * a2[1]);
      if (tok < NTOK) { *(unsigned*)(yb + ((unsigned)tok * (unsigned)D_MODEL + (unsigned)(s * 128 + col))) = pack2(a2[0], a2[1]); if (l == 0) ypart2[(unsigned)s * (unsigned)NTOK + (unsigned)tok] = sq; } };
    long tok = (long)ss.bi * NW + w;
    u32x2 pqCur, pqNext; u32x4 vvA[8], vvB[8]; unsigned wgA[4], wgB[4];
    ldmeta(tok, pqCur); issue_half(pqCur, 0, vvA, wgA); ldmeta(tok + tstep, pqNext);
    for (; tok < NTOK; tok += tstep) {
      u32x2 pqN2; issue_half(pqCur, 1, vvB, wgB); ldmeta(tok + 2 * tstep, pqN2);
      f32x2 acc[8];
#pragma unroll
      for (int j = 0; j < 8; ++j) acc[j] = (f32x2){0.f, 0.f};
      acc_half(vvA, wgA, acc);
      issue_half(pqNext, 0, vvA, wgA);
      acc_half(vvB, wgB, acc);
      finish(tok, acc);
      pqCur = pqNext; pqNext = pqN2;
    }
  }
}
DI void phase_peer_final(const Params& p) {
  const int t_ = tid(); const int w = t_ >> 6, l = t_ & 63; const float* mod = WSP(const float, mod); const bf16_t* yb = WSP(const bf16_t, yb); const float* ypart2 = WSP(const float, ypart2);
  for (long row = (long)blockIdx.x * NW + w; row < NTOK; row += (long)gridDim.x * NW) { const int b = (int)(row / SEQ); const float* mb = mod + (long)b * 6 * D_MODEL + 5 * D_MODEL;
    const float rs = row_rstd(ypart2, NSL, row, D_MODEL);
#pragma unroll
    for (int i = 0; i < RV; ++i) { const int c0 = (i * 64 + l) * 4; const u32x2 yy = *(const u32x2*)(yb + row * D_MODEL + c0); const f32x4 yv = {bflo(yy[0]), bfhi(yy[0]), bflo(yy[1]), bfhi(yy[1])};
      float* op = p.out + row * D_MODEL + c0; const f32x4 g = *(const f32x4*)(p.ffn_post_g + c0), gf = *(const f32x4*)(mb + c0);
      *(f32x4*)op = *(const f32x4*)op + gf * (yv * rs * g); } }
}

#ifdef HOST_EMU
struct GridBar { int dummy; };
DI GridBar gridbar_init(const Params&, char*) { return GridBar{0}; }
DI void gsync(const GridBar&) { emu_grid_sync(); }
#else
#define XB_TMO      128
#define XB_XCNT(j)  (256  + 64 * (j))
#define XB_XSUB(j)  (1280 + 64 * (j))
#define XB_XGEN(j)  (2304 + 64 * (j))
#define XB_TOP      3328
#define XB_TOPGEN   3392
#define XCD_BAR_WORDS 3456
#define XB_SPIN_CAP (1u << 22)
DI unsigned xb_ld(unsigned* p) { return __hip_atomic_load(p, __ATOMIC_RELAXED, __HIP_MEMORY_SCOPE_AGENT); }
DI unsigned xb_add(unsigned* p, unsigned v) { return __hip_atomic_fetch_add(p, v, __ATOMIC_RELAXED, __HIP_MEMORY_SCOPE_AGENT); }
DI unsigned xb_xcc_id() { return (unsigned)__builtin_amdgcn_s_getreg((3 << 11) | 20) & 0xFu; }
#define XB_SPIN(cond, bar) do { unsigned _sp = 0; while (cond) { __builtin_amdgcn_s_sleep(1); \
    if ((++_sp & 255u) == 0u) { if (xb_ld(&(bar)[XB_TMO])) break; if (_sp > XB_SPIN_CAP) { atomicAdd(&(bar)[XB_TMO], 1u); break; } } } } while (0)
struct GridBar { unsigned* bar; unsigned x; volatile unsigned* st; };
DI GridBar gridbar_init(const Params& p, char* lds) {
  GridBar b; b.bar = (unsigned*)(p.ws + WL.bar); b.x = xb_xcc_id(); b.st = (volatile unsigned*)(lds + LDS_MAIN);
  if (threadIdx.x == 0) { b.st[0] = 0u; b.st[1] = 0u; (void)xb_add(&b.bar[XB_XCNT(b.x)], 1u); }
  __syncthreads();
  return b;
}
DI void xb_complete(unsigned* bar, unsigned x, unsigned& nloc, unsigned& nx) {
  const unsigned G = gridDim.x; unsigned sum, cnt, mine, sp = 0u;
  for (;;) { sum = 0u; cnt = 0u; mine = 0u;
#pragma unroll
    for (unsigned j = 0; j < 16; ++j) { const unsigned c = xb_ld(&bar[XB_XCNT(j)]); sum += c; cnt += (c > 0u) ? 1u : 0u; mine = (j == x) ? c : mine; }
    if (sum == G) break;
    __builtin_amdgcn_s_sleep(1);
    if ((++sp & 255u) == 0u) { if (xb_ld(&bar[XB_TMO])) break; if (sp > XB_SPIN_CAP) { atomicAdd(&bar[XB_TMO], 1u); break; } } }
  nloc = mine > 0u ? mine : 1u; nx = cnt > 0u ? cnt : 1u;
}
DI void gsync(const GridBar& b) {
  asm volatile("s_waitcnt vmcnt(0)" ::: "memory");
  __syncthreads();
  if (threadIdx.x == 0) {
    unsigned* bar = b.bar;
    __builtin_amdgcn_s_waitcnt(0);
    unsigned nloc = b.st[0], nx = b.st[1];
    if (nloc == 0u) { xb_complete(bar, b.x, nloc, nx); b.st[0] = nloc; b.st[1] = nx; }
    const unsigned old = xb_add(&bar[XB_XSUB(b.x)], 1u);
    const unsigned gen = old / nloc;
    if (old + 1u == (gen + 1u) * nloc) {
      __builtin_amdgcn_fence(__ATOMIC_RELEASE, "agent");
      asm volatile("s_waitcnt vmcnt(0)" ::: "memory");
      const unsigned og = xb_add(&bar[XB_TOP], 1u);
      const unsigned tg = og / nx;
      if (og + 1u == (tg + 1u) * nx) xb_add(&bar[XB_TOPGEN], 1u);
      else XB_SPIN(xb_ld(&bar[XB_TOPGEN]) == tg, bar);
      __builtin_amdgcn_fence(__ATOMIC_ACQUIRE, "agent");
      xb_add(&bar[XB_XGEN(b.x)], 1u);
      asm volatile("s_waitcnt vmcnt(0)" ::: "memory");
    } else {
      XB_SPIN(xb_ld(&bar[XB_XGEN(b.x)]) == gen, bar);
      __builtin_amdgcn_fence(__ATOMIC_ACQUIRE, "agent");
      asm volatile("s_waitcnt vmcnt(0)" ::: "memory");
    }
  }
  __syncthreads();
}
#endif

#ifdef HOST_EMU
#define PLOAD(parg) (parg)
#else
DI Params pload_kernarg() {
#if defined(__HIP_DEVICE_COMPILE__)
  const __attribute__((address_space(4))) Params* kp = (const __attribute__((address_space(4))) Params*)__builtin_amdgcn_kernarg_segment_ptr(); asm volatile("" : "+s"(kp)); return *kp;
#else
  return Params{};
#endif
}
#define PLOAD(parg) pload_kernarg()
#endif
#ifndef HOST_EMU
__global__ __launch_bounds__(NTHREADS, 2)
#endif
void fwd_kernel(Params p_arg) {
  char* lds = LDS_PTR();
  GridBar gb; { const Params p = PLOAD(p_arg); gb = gridbar_init(p, lds); }
  const int G = gridDim.x, bid = blockIdx.x;
  for (int rep = 0; rep < REPS(0); ++rep) if (PH_ON(0)) { const Params p = PLOAD(p_arg); phase0(p, lds); }
  grid_sync();
  for (int rep = 0; rep < REPS(1); ++rep) if (PH_ON(1)) { const Params p = PLOAD(p_arg); phase_prenorm(p); }
  gsync(gb);
  for (int rep = 0; rep < REPS(2); ++rep) if (PH_ON(2)) { const Params p = PLOAD(p_arg); const int nM = (NTOK + 255) / 256, nN = (NPROJ + 255) / 256;
    for (int tile = bid; tile < nM * nN; tile += G) { const int mt = tile % nM, nt = tile / nM;
      gemm_tile8(WSP(const bf16_t, h), D_MODEL, NTOK, mt * 256, WSP(const bf16_t, WinT) + (long)nt * 256 * D_MODEL, D_MODEL, NPROJ_VALID - nt * 256, D_MODEL, lds, [&](int hn) { const int q = (nt * 256 + hn * 128) >> 7; return q >= 20 && q < NT_LAST; },
                 [&](const float* st, int m0, int nq) { epi_proj(p, st, m0, nt * 256 + nq); }, [&](int row, int col, const f32x4& v0, const f32x4& v1, int nq) { epid_proj(p, row, col, v0, v1, nt * 256 + nq); }); }
    { const int ntl = nM * nN, rem = ntl % G, nlight = rem ? G - rem : 0; constexpr int KL = 22;
      int part = KL * nlight; if (part > 2 * TAB_N) part = 2 * TAB_N;
      if (nlight && bid >= rem) tab_items(p, lds, bid - rem, nlight, part);
      tab_items(p, lds, part + bid, G, 2 * TAB_N); } }
  gsync(gb);
  for (int rep = 0; rep < REPS(3); ++rep) if (PH_ON(3)) { const Params p = PLOAD(p_arg); constexpr int MC = BATCH * NG * NCP; const int nMc = (MC + 255) / 256, nc = 2 * nMc, nMt = (NTOK + 255) / 256, nq = nMt * (NH * MQK / 256), nkv = nMt * (NH / 2);
    const int hole = G > nc ? nc : 0;
    for (int j = 0;; ++j) { int tile;
      if (j < 2 || !hole) tile = j * G + bid; else { if (bid < hole) break; tile = 2 * G + (j - 2) * (G - hole) + (bid - hole); }
      if (tile >= nc + nq + nkv) break;
      if (tile < nc) { const int which = tile / nMc, mt = tile % nMc;
        gemm_tile8(which == 0 ? WSP(const bf16_t, KcR) : WSP(const bf16_t, VcR), 1024, MC, mt * 256, WSP(const bf16_t, W1T) + (long)which * CMP_HIDDEN * 2048, 2048, CMP_HIDDEN, 2048, lds,
                  [&](int) { return true; }, [&](const float* st, int m0, int nq_) { epi_cmp1(p, st, m0, nq_, which); }, [&](int row, int col, const f32x4& v0, const f32x4& v1, int nq_) { epid_cmp1(p, row, nq_ + col, v0, v1, which); });
#ifndef HOST_EMU
        __builtin_amdgcn_fence(__ATOMIC_RELEASE, "agent"); __syncthreads(); __builtin_amdgcn_fence(__ATOMIC_ACQUIRE, "agent");
#else
        __syncthreads();
#endif
        gemm_tile(WSP(const bf16_t, hid) + (long)which * MC * CMP_HIDDEN, CMP_HIDDEN, MC, mt * 256, WSP(const bf16_t, W2T) + (long)which * 128 * CMP_HIDDEN, CMP_HIDDEN, 128, CMP_HIDDEN, lds,
                  [&](const float* st, int m0, int) { epi_cmp2(p, st, m0, which); });
      } else if (tile < nc + nq) { const int r = tile - nc, mt = r % nMt, nt = r / nMt; tile_rstd(WSP(const float, cqpart), 16, mt * 256, QR, lds);
        gemm_tile8(WSP(const bf16_t, cq), QR, NTOK, mt * 256, WSP(const bf16_t, WquT) + (long)nt * 256 * QR, QR, 256, QR, lds, [&](int) { return false; }, [&](const float* st, int m0, int nq_) { epi_qup(p, st, m0, nt * 256 + nq_); }, [&](int, int, const f32x4&, const f32x4&, int) {});
      } else { const int r = tile - nc - nq, mt = r % nMt, nt = r / nMt; tile_rstd(WSP(const float, ckvpart), 8, mt * 256, KVR, lds);
        gemm_tile8(WSP(const bf16_t, ckv), KVR, NTOK, mt * 256, WSP(const bf16_t, WkvT) + (long)nt * 256 * KVR, KVR, 256, KVR, lds, [&](int) { return false; }, [&](const float* st, int m0, int nq_) { epi_kvup(p, st, m0, nt * 256 + nq_, lds); }, [&](int, int, const f32x4&, const f32x4&, int) {});
      } }
    late_conv_items(p, lds, bid, G, LC_TOTAL); }
  gsync(gb);
#ifdef HOST_EMU
  gsync(gb);
#endif
  for (int rep = 0; rep < REPS(5); ++rep) if (PH_ON(5)) { const Params p = PLOAD(p_arg); const int nN = BATCH * NG * (SEQ / 64), nMl = BATCH * NH * (SEQ / 256), total = nN + nMl;
    for (int j = 0;; ++j) { const long rank = (long)j * G + ((j & 1) ? (G - 1 - bid) : bid); if ((long)j * G >= total) break; if (rank >= total) continue;
      int isn, idx; const int pairs = nN < nMl ? nN : nMl;
      if (rank < 2 * pairs) { isn = (rank & 1) == 0; idx = (int)(rank >> 1); } else { isn = nN > nMl; idx = (int)(rank - pairs); }
#ifdef NO_NSA
      if (0) {}
#else
      if (isn) { const int ti = (SEQ / 64 - 1) - idx / (BATCH * NG), bgx = idx % (BATCH * NG); nsa_tile(p, bgx / NG, bgx % NG, ti * 64, lds); }
#endif
#ifndef NO_MLA
      else { const int ti = (SEQ / 256 - 1) - idx / (BATCH * NH), bh = idx % (BATCH * NH); mla_tile(p, bh / NH, bh % NH, ti * 256, lds); }
#endif
      __syncthreads(); } }
  gsync(gb);
  for (int rep = 0; rep < REPS(6); ++rep) if (PH_ON(6)) { const Params p = PLOAD(p_arg); const int nM = (NTOK + 255) / 256, nN = D_MODEL / 256;
    for (int tile = bid; tile < nM * nN; tile += G) { const int mt = tile % nM, nt = tile / nM;
      const bf16_t* gm = (const bf16_t*)p.out; bf16_t* mg = WSP(bf16_t, merged);
      gemm_tile8_merge(WSP(const bf16_t, on), WSP(const bf16_t, WnT) + (long)nt * 256 * 1024, WSP(const bf16_t, om), WSP(const bf16_t, WmT) + (long)nt * 256 * 1024, 1024, mt * 256, 1024, lds,
        [&](int row, int col, f32x4& g0, f32x4& g1) __attribute__((always_inline)) { const bf16_t* gp = gm + (long)row * (2 * D_MODEL) + nt * 256 + col; const u32x2 a = *(const u32x2*)gp, b = *(const u32x2*)(gp + D_MODEL);
          g0 = (f32x4){bflo(a[0]), bfhi(a[0]), bflo(a[1]), bfhi(a[1])}; g1 = (f32x4){bflo(b[0]), bfhi(b[0]), bflo(b[1]), bfhi(b[1])}; },
        [&](int row, int col, const f32x4& v) __attribute__((always_inline)) { *(u32x2*)(mg + (long)row * D_MODEL + nt * 256 + col) = pack4(v); }); } }
  gsync(gb);
  for (int rep = 0; rep < REPS(7); ++rep) if (PH_ON(7)) { const Params p = PLOAD(p_arg); const int nM = (NTOK + 255) / 256, nN = D_MODEL / 256;
    for (int tile = bid; tile < nM * nN; tile += G) { const int mt = tile % nM, nt = tile / nM;
      gemm_tile8(WSP(const bf16_t, merged), D_MODEL, NTOK, mt * 256, WSP(const bf16_t, WoT) + (long)nt * 256 * D_MODEL, D_MODEL, 256, D_MODEL, lds, [&](int) { return true; }, [&](const float* st, int m0, int nq) { epi_wout(p, st, m0, nt * 256 + nq); }, [&](int row, int col, const f32x4& v0, const f32x4& v1, int nq) { epid_store_bf16(WSP(bf16_t, y), D_MODEL, row, nt * 256 + nq + col, v0, v1); }); } }
  gsync(gb);
  for (int rep = 0; rep < REPS(8); ++rep) if (PH_ON(8)) { const Params p = PLOAD(p_arg); phase_postattn(p); }
  gsync(gb);
  for (int rep = 0; rep < REPS(9); ++rep) if (PH_ON(9)) { const Params p = PLOAD(p_arg); const int nM = (NTOK + 255) / 256, nN = 2048 / 256;
    for (int tile = bid; tile < nM * nN; tile += G) { const int mt = tile % nM, nt = tile / nM;
      gemm_tile8(WSP(const bf16_t, h2), D_MODEL, NTOK, mt * 256, WSP(const bf16_t, WpqT) + (long)nt * 256 * D_MODEL, D_MODEL, 256, D_MODEL, lds, [&](int) { return true; }, [&](const float* st, int m0, int nq) { epi_pq(p, st, m0, nt * 256 + nq); }, [&](int row, int col, const f32x4& v0, const f32x4& v1, int nq) { epid_store_bf16(WSP(bf16_t, qry), 2048, row, nt * 256 + nq + col, v0, v1); }); } }
  gsync(gb);
  for (int rep = 0; rep < REPS(10); ++rep) if (PH_ON(10)) { const Params p = PLOAD(p_arg); const int nM = (NTOK + 255) / 256;
    for (int tile = bid; tile < nM * 16; tile += G) { const int mt = tile % nM, hp = tile / nM;
      gemm_tile(WSP(const bf16_t, qry) + hp * 128, 2048, NTOK, mt * 256, WSP(const bf16_t, SK) + (long)hp * 128 * 128, 128, 128, 128, lds, [&](const float* st, int m0, int) { epi_sc(p, st, m0, hp * 128); }); } }
  gsync(gb);
  for (int rep = 0; rep < REPS(11); ++rep) if (PH_ON(11)) { const Params p = PLOAD(p_arg); phase_peer_topk(p); }
  gsync(gb);
  for (int rep = 0; rep < REPS(12); ++rep) if (PH_ON(12)) { const Params p = PLOAD(p_arg); phase_peer_u(p); }
  gsync(gb);
  for (int rep = 0; rep < REPS(13); ++rep) if (PH_ON(13)) { const Params p = PLOAD(p_arg); phase_peer_w(p); }
  gsync(gb);
  for (int rep = 0; rep < REPS(14); ++rep) if (PH_ON(14)) { const Params p = PLOAD(p_arg); phase_peer_v(p); }
  gsync(gb);
  if (PH_ON(15)) { const Params p = PLOAD(p_arg); phase_peer_final(p); }
}

#ifndef HOST_EMU
extern "C" void kernel_launch(void* const* d_in, const int* in_sizes, int n_in, void* d_out, int out_size, void* d_ws, size_t ws_size, hipStream_t stream) {
  static int grid_blocks = 0;
  if (!grid_blocks) {
    int dev = 0, cus = 0, per_cu = 0;
    (void)hipGetDevice(&dev);
    (void)hipDeviceGetAttribute(&cus, hipDeviceAttributeMultiprocessorCount, dev);
    (void)hipFuncSetAttribute((const void*)fwd_kernel, hipFuncAttributeMaxDynamicSharedMemorySize, LDS_BYTES);
    (void)hipOccupancyMaxActiveBlocksPerMultiprocessor(&per_cu, fwd_kernel, NTHREADS, LDS_BYTES);
    per_cu = 1;
    grid_blocks = cus * per_cu;
  }
  Params p{};
  p.x = (const float*)d_in[0]; p.c = (const float*)d_in[1]; p.pos = (const int*)d_in[2];
  { int i = 3;
    p.ada_w = (const float*)d_in[i++]; p.ada_b = (const float*)d_in[i++]; p.attn_pre_g = (const float*)d_in[i++]; p.attn_post_g = (const float*)d_in[i++];
    p.w_in = (const float*)d_in[i++]; p.cmp_pe = (const float*)d_in[i++]; p.cmp_w1 = (const float*)d_in[i++]; p.cmp_b1 = (const float*)d_in[i++]; p.cmp_w2 = (const float*)d_in[i++];
    p.mla_q_norm_g = (const float*)d_in[i++]; p.mla_w_q_up = (const float*)d_in[i++]; p.mla_kv_norm_g = (const float*)d_in[i++]; p.mla_w_kv_up = (const float*)d_in[i++];
    p.w_branch_nsa = (const float*)d_in[i++]; p.w_branch_mla = (const float*)d_in[i++]; p.w_out = (const float*)d_in[i++]; p.ffn_pre_g = (const float*)d_in[i++]; p.ffn_post_g = (const float*)d_in[i++];
    p.peer_w_q = (const float*)d_in[i++]; p.peer_sub_keys = (const float*)d_in[i++]; p.peer_u = (const float*)d_in[i++]; p.peer_v = (const float*)d_in[i++]; }
  p.out = (float*)d_out; p.ws = (char*)d_ws;
  if (ws_size < WL.total) { fprintf(stderr, "workspace too small: %zu < %zu\n", ws_size, (size_t)WL.total); return; }
  (void)hipMemsetAsync((char*)d_ws + WL.bar, 0, 16384, stream);
  void* args[] = {&p};
  hipError_t e = hipLaunchCooperativeKernel((void*)fwd_kernel, dim3(grid_blocks), dim3(NTHREADS), args, LDS_BYTES, stream);
  if (e != hipSuccess) fprintf(stderr, "cooperative launch failed: %s (grid %d)\n", hipGetErrorString(e), grid_blocks);
}
#endif
```

```cpp
#ifdef HOST_EMU
#include "emu.h"
#else
#include <hip/hip_runtime.h>
#include <hip/hip_cooperative_groups.h>
#include <cstdio>
namespace cg = cooperative_groups;
#endif
#include <stdint.h>

#define DI __device__ __forceinline__

#ifdef SMALL_CFG
constexpr int D_MODEL = 512, BATCH = 1, SEQ = 2048;
#else
constexpr int D_MODEL = 2048, BATCH = 4, SEQ = 4096;
#endif
constexpr int NTOK = BATCH * SEQ;
constexpr int NH = 16, NG = 4, HD = 64;
constexpr int CMP_HIDDEN = 256;
constexpr int NCP = SEQ / 16;
constexpr int NSEL = SEQ / 64;
constexpr int WINDOW = 512;
constexpr int QR = 512, KVR = 256;
constexpr int MQK = 96;
constexpr int PH = 8, PNK = 128, PQD = 256, PTOPK = 16;
constexpr int NEXP = PNK * PNK;
constexpr int NPICK = PH * PTOPK;
constexpr float NORM_EPS = 1e-6f;
constexpr int IN_COLS = 1024 + 1536 + 48 + 512 + 256 + 32 + 2 * D_MODEL;
constexpr int PC_Q = 0, PC_KV = 1024, PC_CQ = 2560, PC_CKV = 3072, PC_GM = 3328, PC_KR = PC_GM + 2 * D_MODEL, PC_GN = PC_KR + 32;
constexpr int NPROJ = ((PC_GN + 48 + 255) / 256) * 256;
constexpr int NPROJ_VALID = ((PC_GN + 48 + 127) / 128) * 128;
constexpr int GMT = 2 * D_MODEL / 128;
constexpr int NT_LAST = 26 + GMT;
static_assert(NPROJ_VALID / 128 == NT_LAST + 1, "proj tiles");
static_assert((NTOK * NG / 16) % 256 == 0 && NTOK % 256 == 0 && SEQ % 256 == 0, "row tiling");

#ifndef PH_MASK
#define PH_MASK 0xFFFF
#endif
#define PH_ON(k) (((PH_MASK) >> (k)) & 1)
#ifndef REP
#define REP (-1)
#endif
#define REPS(k) ((REP) == (k) ? 2 : 1)
constexpr int NTHREADS = 512, NW = NTHREADS / 64;
constexpr int LDS_MAIN = 147456;
constexpr int LDS_BYTES = LDS_MAIN + 256;
constexpr int ST_LD = 129;
constexpr int AB_STR = 144;

typedef unsigned short bf16_t;
typedef short bf16x8 __attribute__((ext_vector_type(8)));
typedef short bf16x4 __attribute__((ext_vector_type(4)));
typedef float f32x16 __attribute__((ext_vector_type(16)));
typedef float f32x4 __attribute__((ext_vector_type(4)));
typedef float f32x2 __attribute__((ext_vector_type(2)));
typedef unsigned u32x4 __attribute__((ext_vector_type(4)));
typedef unsigned u32x2 __attribute__((ext_vector_type(2)));

DI float u2f(unsigned u) { float f; __builtin_memcpy(&f, &u, 4); return f; }
DI unsigned f2u(float f) { unsigned u; __builtin_memcpy(&u, &f, 4); return u; }
DI float bf2f(bf16_t v) { return u2f((unsigned)v << 16); }
DI float bflo(unsigned u) { return u2f(u << 16); }
DI float bfhi(unsigned u) { return u2f(u & 0xffff0000u); }
#ifdef HOST_EMU
DI bf16_t f2bf(float x) { unsigned u = f2u(x); u += 0x7fffu + ((u >> 16) & 1u); return (bf16_t)(u >> 16); }
DI unsigned pack2(float lo, float hi) { return (unsigned)f2bf(lo) | ((unsigned)f2bf(hi) << 16); }
DI float fexp2(float x) { return exp2f(x); }
DI float frcp(float x) { return 1.0f / x; }
DI float frsq(float x) { return 1.0f / sqrtf(x); }
DI float fsin_rev(float x) { return sinf(6.283185307179586f * x); }
DI float fcos_rev(float x) { return cosf(6.283185307179586f * x); }
DI int bcast_i(int v, int l) { return __shfl(v, l); }
DI void grid_sync() { emu_grid_sync(); }
#define LDS_PTR() (emu_cur->blk->smem)
#else
typedef __bf16 bf16v2 __attribute__((ext_vector_type(2)));
DI unsigned pack2(float lo, float hi) { f32x2 v = {lo, hi}; bf16v2 r = __builtin_convertvector(v, bf16v2); return __builtin_bit_cast(unsigned, r); }
DI bf16_t f2bf(float x) { return (bf16_t)(pack2(x, 0.f) & 0xffffu); }
DI float fexp2(float x) { return __builtin_amdgcn_exp2f(x); }
DI float frcp(float x) { return __builtin_amdgcn_rcpf(x); }
DI float frsq(float x) { return __builtin_amdgcn_rsqf(x); }
DI float fsin_rev(float x) { return __builtin_amdgcn_sinf(x); }
DI float fcos_rev(float x) { return __builtin_amdgcn_cosf(x); }
DI int bcast_i(int v, int l) { return __builtin_amdgcn_readlane(v, l); }
DI void grid_sync() { cg::this_grid().sync(); }
extern __shared__ __attribute__((aligned(16))) char dyn_lds[];
#define LDS_PTR() (dyn_lds)
#endif
DI float bcast_f(float v, int l) { return u2f((unsigned)bcast_i((int)f2u(v), l)); }
DI int shfl_i(int v, int l) { return __shfl(v, l); }
DI float shfl_f(float v, int l) { return __shfl(v, l); }
#ifdef HOST_EMU
DI int tid() { return threadIdx.x; }
#else
DI int tid() { int t = threadIdx.x; asm volatile("" : "+v"(t)); return t; }
#endif
#ifdef HOST_EMU
#define GLD16(ptr) (*(const u32x4*)(ptr))
#else
#define GLD16(ptr) (*(const __attribute__((address_space(1))) u32x4*)(const __attribute__((address_space(1))) void*)(ptr))
#endif
DI float fsigmoid(float x) { return frcp(1.0f + fexp2(-1.4426950408889634f * x)); }
DI float fgelu_tanh(float x) { const float z2 = 2.0f * 0.7978845608028654f * (x + 0.044715f * x * x * x); return x * frcp(1.0f + fexp2(-1.4426950408889634f * z2)); }

#ifdef HOST_EMU
DI unsigned emu_f2e4m3(float x) { unsigned sgn = x < 0 ? 0x80u : 0u; float a = fabsf(x); if (!(a == a)) return sgn | 0x7f; if (a > 448.f) a = 448.f;
  if (a < 0.0009765625f) return sgn;
  int e; frexpf(a, &e); int ex = e - 1; if (ex < -6) ex = -6;
  float q = ldexpf(a, 3 - ex); float r = nearbyintf(q);
  if (r >= 16.f) { r = 8.f; ex += 1; }
  unsigned bits; if (r < 8.f) bits = (unsigned)r; else bits = ((unsigned)(ex + 7) << 3) | ((unsigned)r - 8u);
  if (bits > 0x7e) bits = 0x7e; return sgn | bits; }
DI float emu_e4m32f(unsigned b) { const float sg = (b & 0x80u) ? -1.f : 1.f; const unsigned ex = (b >> 3) & 15u, m = b & 7u; if (ex == 0) return sg * ldexpf((float)m, -9); return sg * ldexpf((float)(8 + m), (int)ex - 10); }
DI unsigned enc_fp8x4(float a, float b, float c, float d) { return emu_f2e4m3(a) | (emu_f2e4m3(b) << 8) | (emu_f2e4m3(c) << 16) | (emu_f2e4m3(d) << 24); }
DI f32x2 dec_fp8_lo(unsigned w) { return (f32x2){emu_e4m32f(w & 0xff), emu_e4m32f((w >> 8) & 0xff)}; }
DI f32x2 dec_fp8_hi(unsigned w) { return (f32x2){emu_e4m32f((w >> 16) & 0xff), emu_e4m32f(w >> 24)}; }
#else
DI unsigned enc_fp8x4(float a, float b, float c, float d) { int r = __builtin_amdgcn_cvt_pk_fp8_f32(a, b, 0, false); r = __builtin_amdgcn_cvt_pk_fp8_f32(c, d, r, true); return (unsigned)r; }
DI f32x2 dec_fp8_lo(unsigned w) { return __builtin_amdgcn_cvt_pk_f32_fp8((int)w, false); }
DI f32x2 dec_fp8_hi(unsigned w) { return __builtin_amdgcn_cvt_pk_f32_fp8((int)w, true); }
#endif
DI float wave_sum(float v) { for (int m = 32; m >= 1; m >>= 1) v += __shfl_xor(v, m); return v; }
DI f32x4 mfma16(bf16x8 a, bf16x8 b, f32x4 c) { return __builtin_amdgcn_mfma_f32_16x16x32_bf16(a, b, c, 0, 0, 0); }
DI f32x16 mfma32(bf16x8 a, bf16x8 b, f32x16 c) { return __builtin_amdgcn_mfma_f32_32x32x16_bf16(a, b, c, 0, 0, 0); }
DI int crow(int i, int h) { return (i & 3) + 8 * (i >> 2) + 4 * h; }
DI f32x16 zero16() { f32x16 z; for (int i = 0; i < 16; ++i) z[i] = 0.f; return z; }

constexpr size_t al256(size_t x) { return (x + 255) & ~(size_t)255; }
struct WsLayout {
  size_t bar, uinv, vinv, W1T, W2T, WquT, WkvT, WnT, WmT, WoT, WpqT, SK, U16, V16, cmpbias, ropeN, ropeM, mod, ovlT;
  size_t WinT, h, on, om, h2;
  size_t Qn, KcR, VcR, Ks, Kw, VsT, VwT, gn, cq, ckv, kr, cqpart, ckvpart, merged, qry, yb, pw, ypart2;
  size_t Qm, Km, VmT, hid, Kc, VcT, y, ypart, sc, apart;
  size_t picks;
  size_t total;
};
constexpr WsLayout make_layout() {
  WsLayout L{}; size_t o = 0;
  auto take = [&](size_t bytes) { size_t r = o; o = al256(o + bytes); return r; };
  L.bar = take(16384);
  L.uinv = take((size_t)NEXP * 4); L.vinv = take((size_t)NEXP * 4);
  L.W1T = take((size_t)2 * CMP_HIDDEN * 2048 * 2);
  L.W2T = take((size_t)2 * 128 * CMP_HIDDEN * 2);
  L.WquT = take((size_t)NH * MQK * QR * 2);
  L.WkvT = take((size_t)NH * 128 * KVR * 2);
  L.WnT = take((size_t)D_MODEL * 1024 * 2);
  L.WmT = take((size_t)D_MODEL * 1024 * 2);
  L.WoT = take((size_t)D_MODEL * D_MODEL * 2);
  L.WpqT = take((size_t)2048 * D_MODEL * 2);
  L.SK = take((size_t)16 * 128 * 128 * 2);
  L.U16 = take((size_t)NEXP * D_MODEL * 2);
  L.V16 = take((size_t)NEXP * D_MODEL * 2);
  L.cmpbias = take(2 * CMP_HIDDEN * 4);
  L.ropeN = take((size_t)NTOK * 16 * 4);
  L.ropeM = take((size_t)NTOK * 32 * 4);
  L.mod = take((size_t)BATCH * 6 * D_MODEL * 4);
  L.ovlT = take((size_t)64 * NCP * 2 + 4096);
  size_t r1 = o;
  L.WinT = take((size_t)NPROJ * D_MODEL * 2);
  L.h = take((size_t)NTOK * D_MODEL * 2);
  size_t r1end = o;
  o = r1; L.on = take((size_t)NTOK * 1024 * 2); L.om = take((size_t)NTOK * 1024 * 2);
  if (o > r1end) r1end = o;
  o = r1; L.h2 = take((size_t)NTOK * D_MODEL * 2);
  if (o > r1end) r1end = o;
  o = r1end;
  size_t r2 = o;
  L.Qn = take((size_t)NTOK * 1024 * 2);
  L.KcR = take((size_t)NTOK * 256 * 2 + 8192);
  L.VcR = take((size_t)NTOK * 256 * 2 + 8192);
  L.Ks = take((size_t)NTOK * 256 * 2);
  L.Kw = take((size_t)NTOK * 256 * 2);
  L.VsT = take((size_t)NTOK * 256 * 2);
  L.VwT = take((size_t)NTOK * 256 * 2);
  L.gn = take((size_t)NTOK * 48 * 4);
  L.cq = take((size_t)NTOK * QR * 2);
  L.ckv = take((size_t)NTOK * KVR * 2);
  L.kr = take((size_t)NTOK * 32 * 4);
  L.cqpart = take((size_t)16 * NTOK * 4);
  L.ckvpart = take((size_t)8 * NTOK * 4);
  size_t r2end = o;
  o = r2; L.merged = take((size_t)NTOK * D_MODEL * 2); if (o > r2end) r2end = o;
  o = r2; L.qry = take((size_t)NTOK * 2048 * 2); if (o > r2end) r2end = o;
  o = r2; L.yb = take((size_t)NTOK * D_MODEL * 2); L.pw = take((size_t)NTOK * NPICK * 4); L.ypart2 = take((size_t)(D_MODEL / 128) * NTOK * 4); if (o > r2end) r2end = o;
  o = r2end;
  size_t r3 = o;
  L.Qm = take((size_t)NTOK * NH * MQK * 2);
  L.Km = take((size_t)NTOK * NH * MQK * 2);
  L.VmT = take((size_t)NTOK * NH * 64 * 2);
  L.hid = take((size_t)2 * BATCH * NG * NCP * CMP_HIDDEN * 2);
  L.Kc = take((size_t)BATCH * NG * NCP * 64 * 2 + 16384);
  L.VcT = take((size_t)BATCH * NG * 64 * NCP * 2 + 16384);
  size_t r3end = o;
  o = r3; L.y = take((size_t)NTOK * D_MODEL * 2); L.ypart = take((size_t)(D_MODEL / 128) * NTOK * 4); if (o > r3end) r3end = o;
  o = r3; L.sc = take((size_t)NTOK * 2048 * 4); if (o > r3end) r3end = o;
  o = r3; L.apart = take((size_t)(D_MODEL / 128) * NTOK * NPICK * 2); if (o > r3end) r3end = o;
  o = r3end;
  L.picks = take((size_t)NTOK * NPICK * 8);
  L.total = o;
  return L;
}
constexpr WsLayout WL = make_layout();

struct Params {
  const float *x, *c; const int* pos;
  const float *ada_w, *ada_b, *attn_pre_g, *attn_post_g, *w_in, *cmp_pe, *cmp_w1, *cmp_b1, *cmp_w2, *mla_q_norm_g, *mla_w_q_up,
      *mla_kv_norm_g, *mla_w_kv_up, *w_branch_nsa, *w_branch_mla, *w_out, *ffn_pre_g, *ffn_post_g, *peer_w_q, *peer_sub_keys, *peer_u, *peer_v;
  float* out; char* ws;
};
#define WSP(T, name) ((T*)(p.ws + WL.name))

#ifdef HOST_EMU
DI void glds16(const void* g, char* lds_wave_base) { __builtin_memcpy(lds_wave_base + (tid() & 63) * 16, g, 16); }
#else
DI void glds16(const void* g, char* lds_wave_base) { __builtin_amdgcn_global_load_lds((const unsigned*)g, (unsigned*)lds_wave_base, 16, 0, 0); }
#endif
#ifdef HOST_EMU
#define SCHED_FENCE() do {} while (0)
DI void wait_vm4() {} DI void wait_vm0() {} DI void raw_barrier() { __syncthreads(); }
#else
#define SCHED_FENCE() __builtin_amdgcn_sched_barrier(0)
DI void wait_vm4() { asm volatile("s_waitcnt vmcnt(4)" ::: "memory"); }
DI void wait_vm0() { asm volatile("s_waitcnt vmcnt(0)" ::: "memory"); }
DI void raw_barrier() { asm volatile("s_waitcnt lgkmcnt(0)" ::: "memory"); __builtin_amdgcn_s_barrier(); asm volatile("" ::: "memory"); }
#endif
struct GemmAcc { f32x16 a[4][2]; };
template <int GV> DI f32x16 mfmaV(bf16x8 a, bf16x8 b, f32x16 c) { if (GV & 2) { c[0] += __builtin_bit_cast(float, (int)a[0] + (int)b[0]); return c; } return mfma32(a, b, c); }
template <int GV = 0  > DI void gemm_mainloop(const bf16_t* Ap, long lda, int mrows  , const bf16_t* Bp, long ldb, int nrows  , int K, char* lds, GemmAcc& G) {
  const int t = tid(), w = t >> 6, l = t & 63, wm = w >> 2, wn = w & 3, lr = l & 31, lh = l >> 5;
#pragma unroll
  for (int i = 0; i < 4; ++i)
#pragma unroll
    for (int j = 0; j < 2; ++j) G.a[i][j] = zero16();
  const int nk = K >> 5;
  constexpr int TA = 256 * 64, SB = 2 * TA;
  const bf16_t* ag[2]; const bf16_t* bgp[2];
#pragma unroll
  for (int i = 0; i < 2; ++i) { const int row = 32 * w + 16 * i + (l >> 2); const int c = (l & 3) ^ ((row >> 2) & 3);
    const int ra = row < mrows ? row : mrows - 1, rb = row < nrows ? row : nrows - 1; ag[i] = Ap + (long)ra * lda + c * 8; bgp[i] = Bp + (long)rb * ldb + c * 8; }
  char* s0 = lds; char* s1 = lds + SB; char* s2 = lds + 2 * SB;
#pragma unroll
  for (int pre = 0; pre < 2; ++pre) { char* sb = (pre ? s1 : s0) + (2 * w) * 1024; const int kc = pre < nk ? pre : nk - 1;
#pragma unroll
    for (int i = 0; i < 2; ++i) { if (!(GV & 1)) { glds16(ag[i] + kc * 32, sb + i * 1024); glds16(bgp[i] + kc * 32, sb + TA + i * 1024); } } }
  const int arow = wm * 128 + lr, brow = wn * 64 + lr;
  const int asw = (arow >> 2) & 3, bsw = (brow >> 2) & 3;
  const int ca0 = ((0 + lh) ^ asw) << 4, ca1 = ((2 + lh) ^ asw) << 4, cb0 = ((0 + lh) ^ bsw) << 4, cb1 = ((2 + lh) ^ bsw) << 4;
  for (int kt = 0; kt < nk; ++kt) {
    wait_vm4();
    raw_barrier();
    const char* const cA = s0; const char* const cB = cA + TA;
    const int kn = kt + 2 < nk ? kt + 2 : nk - 1;
    const int ko = kn * 32; char* const nsA = s2 + (2 * w) * 1024; char* const nsB = nsA + TA;
    bf16x8 a0[4], a1[4];
    const bf16x8 b00 = *(const bf16x8*)(cB + brow * 64 + cb0), b01 = *(const bf16x8*)(cB + (brow + 32) * 64 + cb0);
#pragma unroll
    for (int mi = 0; mi < 4; ++mi) a0[mi] = *(const bf16x8*)(cA + (arow + 32 * mi) * 64 + ca0);
    const bf16x8 b10 = *(const bf16x8*)(cB + brow * 64 + cb1), b11 = *(const bf16x8*)(cB + (brow + 32) * 64 + cb1);
#pragma unroll
    for (int mi = 0; mi < 4; ++mi) a1[mi] = *(const bf16x8*)(cA + (arow + 32 * mi) * 64 + ca1);
    SCHED_FENCE();
    G.a[0][0] = mfmaV<GV>(a0[0], b00, G.a[0][0]); G.a[0][1] = mfmaV<GV>(a0[0], b01, G.a[0][1]); SCHED_FENCE(); if (!(GV & 1)) glds16(ag[0] + ko, nsA); SCHED_FENCE();
    G.a[1][0] = mfmaV<GV>(a0[1], b00, G.a[1][0]); G.a[1][1] = mfmaV<GV>(a0[1], b01, G.a[1][1]);
    G.a[2][0] = mfmaV<GV>(a0[2], b00, G.a[2][0]); G.a[2][1] = mfmaV<GV>(a0[2], b01, G.a[2][1]); SCHED_FENCE(); if (!(GV & 1)) glds16(ag[1] + ko, nsA + 1024); SCHED_FENCE();
    G.a[3][0] = mfmaV<GV>(a0[3], b00, G.a[3][0]); G.a[3][1] = mfmaV<GV>(a0[3], b01, G.a[3][1]);
    G.a[0][0] = mfmaV<GV>(a1[0], b10, G.a[0][0]); G.a[0][1] = mfmaV<GV>(a1[0], b11, G.a[0][1]); SCHED_FENCE(); if (!(GV & 1)) glds16(bgp[0] + ko, nsB); SCHED_FENCE();
    G.a[1][0] = mfmaV<GV>(a1[1], b10, G.a[1][0]); G.a[1][1] = mfmaV<GV>(a1[1], b11, G.a[1][1]);
    G.a[2][0] = mfmaV<GV>(a1[2], b10, G.a[2][0]); G.a[2][1] = mfmaV<GV>(a1[2], b11, G.a[2][1]); SCHED_FENCE(); if (!(GV & 1)) glds16(bgp[1] + ko, nsB + 1024); SCHED_FENCE();
    G.a[3][0] = mfmaV<GV>(a1[3], b10, G.a[3][0]); G.a[3][1] = mfmaV<GV>(a1[3], b11, G.a[3][1]);
    SCHED_FENCE();
    char* const tmp = s0; s0 = s1; s1 = s2; s2 = tmp;
  }
  wait_vm0();
  raw_barrier();
}
namespace g8 {
constexpr int BK = 64, HALF = 128, HT = HALF * BK;
DI int lds_byte(int r, int c) { const int st = (r >> 4) * 2 + (c >> 5), rr = r & 15, cc = c & 31, ob = rr * 64 + cc * 2; return st * 1024 + (ob ^ (((ob >> 9) & 1) << 5)); }
DI void stage_rc(int b, int& R, int& C) { const int st = b / 1024, sb = b % 1024, swz = sb ^ (((sb >> 9) & 1) << 5); R = (st >> 1) * 16 + swz / 64; C = (st & 1) * 32 + (swz % 64) / 2; }
}
#ifdef HOST_EMU
#define G8_WAIT_V(n) do {} while (0)
#define G8_WAIT_L(n) do {} while (0)
#define G8_BAR __syncthreads()
#define G8_SCHED do {} while (0)
#define G8_PRIO(x) do {} while (0)
#else
#define G8_WAIT_V(n) asm volatile("s_waitcnt vmcnt(" #n ")" ::: "memory")
#define G8_WAIT_L(n) asm volatile("s_waitcnt lgkmcnt(" #n ")" ::: "memory")
#define G8_BAR __builtin_amdgcn_s_barrier()
#define G8_SCHED __builtin_amdgcn_sched_barrier(0)
#define G8_PRIO(x) __builtin_amdgcn_s_setprio(x)
#endif
struct GemmAcc8 { f32x4 a[2][2][4][2]; };
struct NoMid { DI void operator()(GemmAcc8&) const {} };
template <bool SPLIT = false, class MidF = NoMid> DI void gemm_mainloop8(const bf16_t* A, long lda, int mrows, const bf16_t* Bt, long ldb, int nrows, int K, char* lds, GemmAcc8& G,
                                                                        const bf16_t* A2 = nullptr, const bf16_t* Bt2 = nullptr, int ksplit = 0, MidF mid = MidF()) {
  using namespace g8;
  bf16_t* shm = (bf16_t*)lds;
  const int tx = tid(); const int wid = tx >> 6, lane = tx & 63, wr = wid >> 2, wc = wid & 3, fr = lane & 15, fq = lane >> 4;
#define G8_SA(b, h) (shm + ((b) * 2 + (h)) * HT)
#define G8_SB(b, h) (shm + (4 + (b) * 2 + (h)) * HT)
  unsigned oA[2], oB[2];
#pragma unroll
  for (int i = 0; i < 2; ++i) { int r_, c_; stage_rc(tx * 16 + i * 8192, r_, c_); oA[i] = (unsigned)(r_ * (int)lda + c_) * 2u; oB[i] = (unsigned)(r_ * (int)ldb + c_) * 2u; }
  const int wbase = __builtin_amdgcn_readfirstlane((tx & ~63) * 16);
#define G8_STAGE(P, BASE, LD, br, OFF, kt) do { const bf16_t* _ub = ((SPLIT && (kt) >= ksplit) ? ((BASE) == A ? A2 : Bt2) + (long)((kt) - ksplit) * BK : (BASE) + (long)(kt) * BK) + (long)(br) * (LD); _Pragma("unroll") for (int _i = 0; _i < 2; ++_i) \
    glds16((const char*)_ub + OFF[_i], (char*)(P) + wbase + _i * 8192); } while (0)
#define G8_LDA(dst, b, h) _Pragma("unroll") for (int m = 0; m < 4; ++m) _Pragma("unroll") for (int k = 0; k < 2; ++k) \
    dst[m][k] = *(const bf16x8*)((const char*)G8_SA(b, h) + lds_byte(wr * 64 + m * 16 + fr, k * 32 + fq * 8))
#define G8_LDB(dst, b, h) _Pragma("unroll") for (int n = 0; n < 2; ++n) _Pragma("unroll") for (int k = 0; k < 2; ++k) \
    dst[n][k] = *(const bf16x8*)((const char*)G8_SB(b, h) + lds_byte(wc * 32 + n * 16 + fr, k * 32 + fq * 8))
#define G8_MMA(ai, bj, At, Bq) do { G8_PRIO(1); _Pragma("unroll") for (int m = 0; m < 4; ++m) _Pragma("unroll") for (int n = 0; n < 2; ++n) _Pragma("unroll") for (int k = 0; k < 2; ++k) \
    G.a[ai][bj][m][n] = mfma16(Bq[n][k], At[m][k], G.a[ai][bj][m][n]); G8_PRIO(0); } while (0)
#pragma unroll
  for (int ai = 0; ai < 2; ++ai)
#pragma unroll
    for (int bj = 0; bj < 2; ++bj)
#pragma unroll
      for (int m = 0; m < 4; ++m)
#pragma unroll
        for (int n = 0; n < 2; ++n) G.a[ai][bj][m][n] = (f32x4){0.f, 0.f, 0.f, 0.f};
  bf16x8 At[4][2], B0[2][2], B1[2][2];
  const int nt = K / BK;
  G8_STAGE(G8_SB(0, 0), Bt, ldb, 0, oB, 0); G8_STAGE(G8_SA(0, 0), A, lda, 0, oA, 0);
  G8_STAGE(G8_SB(0, 1), Bt, ldb, HALF, oB, 0); G8_STAGE(G8_SA(0, 1), A, lda, HALF, oA, 0);
  if (wr == 1) G8_BAR;
  G8_WAIT_V(4); G8_BAR;
  G8_STAGE(G8_SB(1, 0), Bt, ldb, 0, oB, 1); G8_STAGE(G8_SA(1, 0), A, lda, 0, oA, 1); G8_STAGE(G8_SB(1, 1), Bt, ldb, HALF, oB, 1);
  G8_WAIT_V(6); G8_BAR;
  for (int t = 0; t < nt - 2; t += 2) {
    G8_LDB(B0, 0, 0); G8_SCHED; G8_LDA(At, 0, 0); G8_STAGE(G8_SA(1, 1), A, lda, HALF, oA, t + 1);
    G8_WAIT_L(8); G8_BAR; G8_WAIT_L(0); G8_MMA(0, 0, At, B0); G8_BAR; G8_SCHED;
    G8_LDB(B1, 0, 1); G8_STAGE(G8_SB(0, 0), Bt, ldb, 0, oB, t + 2);
    G8_BAR; G8_WAIT_L(0); G8_MMA(0, 1, At, B1); G8_BAR;
    G8_LDA(At, 0, 1); G8_STAGE(G8_SA(0, 0), A, lda, 0, oA, t + 2);
    G8_BAR; G8_WAIT_L(0); G8_MMA(1, 0, At, B0); G8_BAR; G8_SCHED;
    G8_STAGE(G8_SB(0, 1), Bt, ldb, HALF, oB, t + 2);
    G8_WAIT_V(6); G8_BAR; G8_MMA(1, 1, At, B1); G8_BAR;
    G8_LDB(B0, 1, 0); G8_SCHED; G8_LDA(At, 1, 0); G8_STAGE(G8_SA(0, 1), A, lda, HALF, oA, t + 2);
    G8_WAIT_L(8); G8_BAR; G8_WAIT_L(0); G8_MMA(0, 0, At, B0); G8_BAR; G8_SCHED;
    G8_LDB(B1, 1, 1); G8_STAGE(G8_SB(1, 0), Bt, ldb, 0, oB, t + 3);
    G8_BAR; G8_WAIT_L(0); G8_MMA(0, 1, At, B1); G8_BAR;
    G8_LDA(At, 1, 1); G8_STAGE(G8_SA(1, 0), A, lda, 0, oA, t + 3);
    G8_BAR; G8_WAIT_L(0); G8_MMA(1, 0, At, B0); G8_BAR; G8_SCHED;
    G8_STAGE(G8_SB(1, 1), Bt, ldb, HALF, oB, t + 3);
    G8_WAIT_V(6); G8_BAR; G8_MMA(1, 1, At, B1); G8_BAR;
    if (SPLIT && t + 2 == ksplit) mid(G);
  }
  { G8_LDB(B0, 0, 0); G8_LDA(At, 0, 0); G8_STAGE(G8_SA(1, 1), A, lda, HALF, oA, nt - 1);
    G8_BAR; G8_WAIT_L(0); G8_MMA(0, 0, At, B0); G8_BAR;
    G8_LDB(B1, 0, 1); G8_BAR; G8_WAIT_L(0); G8_MMA(0, 1, At, B1); G8_BAR;
    G8_LDA(At, 0, 1); G8_WAIT_V(4); G8_BAR; G8_WAIT_L(0); G8_MMA(1, 0, At, B0); G8_MMA(1, 1, At, B1); G8_BAR; }
  { G8_LDB(B0, 1, 0); G8_LDA(At, 1, 0); G8_WAIT_V(2); G8_BAR; G8_WAIT_L(0); G8_MMA(0, 0, At, B0); G8_BAR;
    G8_LDB(B1, 1, 1); G8_WAIT_V(0); G8_BAR; G8_WAIT_L(0); G8_MMA(0, 1, At, B1); G8_BAR;
    G8_LDA(At, 1, 1); G8_BAR; G8_WAIT_L(0); G8_MMA(1, 0, At, B0); G8_MMA(1, 1, At, B1); G8_BAR; }
  if (wr == 0) G8_BAR;
  __syncthreads();
}
DI void gemm_stage_quarter8(const GemmAcc8& G, int ai, int bj, char* lds) {
  const int tx = tid(); const int wid = tx >> 6, lane = tx & 63, wr = wid >> 2, wc = wid & 3, fr = lane & 15, fq = lane >> 4;
  float* st = (float*)lds;
#pragma unroll
  for (int m = 0; m < 4; ++m)
#pragma unroll
    for (int n = 0; n < 2; ++n)
#pragma unroll
      for (int j = 0; j < 4; ++j) st[(wr * 64 + m * 16 + fr) * ST_LD + wc * 32 + n * 16 + fq * 4 + j] = G.a[ai][bj][m][n][j];
  __syncthreads();
}
template <class EpiD> DI void gemm_direct_quarter8(const GemmAcc8& G, int ai, int bj, int row0, EpiD epid) {
  const int tx = tid(); const int wid = tx >> 6, lane = tx & 63, wr = wid >> 2, wc = wid & 3, fr = lane & 15, fq = lane >> 4;
#pragma unroll
  for (int m = 0; m < 4; ++m) epid(row0 + wr * 64 + m * 16 + fr, wc * 32 + fq * 4, G.a[ai][bj][m][0], G.a[ai][bj][m][1]);
}
template <class Sel, class Epi, class EpiD> DI void gemm_tile8(const bf16_t* A, long lda, int M, int m0, const bf16_t* Bp, long ldb, int ncols, int K, char* lds, Sel direct, Epi epi, EpiD epid) {
  GemmAcc8 G; gemm_mainloop8(A + (long)m0 * lda, lda, M - m0, Bp, ldb, ncols, K, lds, G);
#pragma unroll
  for (int hm = 0; hm < 2; ++hm)
#pragma unroll
    for (int hn = 0; hn < 2; ++hn) { if (m0 + hm * 128 < M && hn * 128 < ncols) {
        if (direct(hn)) gemm_direct_quarter8(G, hm, hn, m0 + hm * 128, [&](int row, int col, const f32x4& v0, const f32x4& v1) __attribute__((always_inline)) { epid(row, col, v0, v1, hn * 128); });
        else { gemm_stage_quarter8(G, hm, hn, lds); epi((const float*)lds, m0 + hm * 128, hn * 128); __syncthreads(); } } }
}

DI void gemm_stage_quarter(const GemmAcc& G, int hm, int hn, char* lds) {
  const int t = tid(), w = t >> 6, l = t & 63, wm = w >> 2, wn = w & 3, lr = l & 31, lh = l >> 5;
  float* st = (float*)lds;
  if (wm == hm && (wn >> 1) == hn) {
#pragma unroll
    for (int mi = 0; mi < 4; ++mi)
#pragma unroll
      for (int ni = 0; ni < 2; ++ni)
#pragma unroll
        for (int i = 0; i < 16; ++i) st[(mi * 32 + crow(i, lh)) * ST_LD + (wn & 1) * 64 + ni * 32 + lr] = G.a[mi][ni][i];
  }
  __syncthreads();
}
template <int GV = 0, class Epi> DI void gemm_tile(const bf16_t* A, long lda, int M, int m0, const bf16_t* Bp, long ldb, int ncols  , int K, char* lds, Epi epi) {
  GemmAcc G; gemm_mainloop<GV>(A + (long)m0 * lda, lda, M - m0, Bp, ldb, ncols, K, lds, G);
#pragma unroll
  for (int hm = 0; hm < 2; ++hm)
#pragma unroll
    for (int hn = 0; hn < 2; ++hn) { if (m0 + hm * 128 < M && hn * 128 < ncols) { gemm_stage_quarter(G, hm, hn, lds); epi((const float*)lds, m0 + hm * 128, hn * 128); } __syncthreads(); }
}

template <class GateF, class StoreF> DI void gemm_tile8_merge(const bf16_t* A1, const bf16_t* B1, const bf16_t* A2, const bf16_t* B2, long ld, int m0, int K1, char* lds, GateF gates, StoreF store) {
  GemmAcc8 G;
  auto lanepos = [&](int& row, int& col, int ai, int bj, int m, int n) __attribute__((always_inline)) { const int tx = tid(); const int wid = tx >> 6, lane = tx & 63, wr = wid >> 2, wc = wid & 3, fr = lane & 15, fq = lane >> 4;
    row = m0 + ai * 128 + wr * 64 + m * 16 + fr; col = bj * 128 + wc * 32 + n * 16 + fq * 4; };
  auto mid = [&](GemmAcc8& Gm) __attribute__((always_inline)) {
#pragma unroll
    for (int ai = 0; ai < 2; ++ai)
#pragma unroll
      for (int bj = 0; bj < 2; ++bj)
#pragma unroll
        for (int m = 0; m < 4; ++m)
#pragma unroll
          for (int n = 0; n < 2; ++n) { int row, col; lanepos(row, col, ai, bj, m, n); f32x4 g0, g1; gates(row, col, g0, g1);
#pragma unroll
            for (int j = 0; j < 4; ++j) Gm.a[ai][bj][m][n][j] *= g0[j] * frcp(g1[j]); } };
  gemm_mainloop8<true>(A1 + (long)m0 * ld, ld, 256, B1, ld, 256, 2 * K1, lds, G, A2 + (long)m0 * ld, B2, K1 / 64, mid);
#pragma unroll
  for (int ai = 0; ai < 2; ++ai)
#pragma unroll
    for (int bj = 0; bj < 2; ++bj)
#pragma unroll
      for (int m = 0; m < 4; ++m)
#pragma unroll
        for (int n = 0; n < 2; ++n) { int row, col; lanepos(row, col, ai, bj, m, n); f32x4 g0, g1; gates(row, col, g0, g1); store(row, col, G.a[ai][bj][m][n] * g1); }
}

DI float rope_n(const float* st, int row, int c, const float* rt  ) {
  const int d = c & 63; const float xv = st[row * ST_LD + c];
  if (d >= 16) return xv;
  const int i = d & 7; const float cs = rt[i], sn = rt[8 + i];
  if (d < 8) return xv * cs - st[row * ST_LD + c + 8] * sn;
  return xv * cs + st[row * ST_LD + c - 8] * sn;
}

DI void epi_proj(const Params& p, const float* st, int m0, int n0) {
  const int t = tid(), w = t >> 6, l = t & 63, c = 2 * l;
  const int nt = n0 >> 7, b = m0 / SEQ, t0 = m0 % SEQ;
  const float* ropeN = WSP(const float, ropeN);
  if (nt < 8) {
    bf16_t* Qn = WSP(bf16_t, Qn);
    _Pragma("nounroll") for (int it = 0; it < 128 / NW; ++it) { const int row = it * NW + w; const long tok = m0 + row; const float* rt = ropeN + tok * 16;
      *(unsigned*)(Qn + tok * 1024 + n0 + c) = pack2(rope_n(st, row, c, rt), rope_n(st, row, c + 1, rt)); }
  } else if (nt < 20) {
    const int chunk = (nt - 8) >> 1, g = ((nt - 8) & 1) * 2 + (c >> 6), d = c & 63;
    if (chunk == 0 || chunk == 1 || chunk == 2 || chunk == 4) {
      bf16_t* dst = chunk == 0 ? WSP(bf16_t, KcR) : chunk == 1 ? WSP(bf16_t, VcR) : chunk == 2 ? WSP(bf16_t, Ks) : WSP(bf16_t, Kw);
      const bool rp = (chunk != 1);
      _Pragma("nounroll") for (int it = 0; it < 128 / NW; ++it) { const int row = it * NW + w; const long tok = m0 + row; const float* rt = ropeN + tok * 16;
        float v0, v1; if (rp) { v0 = rope_n(st, row, c, rt); v1 = rope_n(st, row, c + 1, rt); } else { v0 = st[row * ST_LD + c]; v1 = st[row * ST_LD + c + 1]; }
        *(unsigned*)(dst + (((long)(b * NG + g) * SEQ + t0 + row) * 64 + d)) = pack2(v0, v1); }
    } else {
      bf16_t* dst = chunk == 3 ? WSP(bf16_t, VsT) : WSP(bf16_t, VwT);
      _Pragma("nounroll") for (int it = 0; it < 128 / NW; ++it) { const int col = it * NW + w; const int gg = ((nt - 8) & 1) * 2 + (col >> 6), dd = col & 63;
        *(unsigned*)(dst + ((long)((b * NG + gg) * 64 + dd) * SEQ + t0 + 2 * l)) = pack2(st[(2 * l) * ST_LD + col], st[(2 * l + 1) * ST_LD + col]); }
    }
  } else if (nt < 26) {
    const bool isq = nt < 24; const int j = isq ? nt - 20 : nt - 24; const int ld = isq ? QR : KVR;
    bf16_t* dst = isq ? WSP(bf16_t, cq) : WSP(bf16_t, ckv); float* part = isq ? WSP(float, cqpart) : WSP(float, ckvpart);
    _Pragma("nounroll") for (int it = 0; it < 128 / NW; ++it) { const int row = it * NW + w; const long tok = m0 + row;
      *(unsigned*)(dst + tok * ld + j * 128 + c) = pack2(st[row * ST_LD + c], st[row * ST_LD + c + 1]); }
    if (t < 128) { float sq = 0.f;
#pragma unroll 8
      for (int cc = 0; cc < 128; ++cc) { const float v = st[t * ST_LD + cc]; sq += v * v; }
      part[(long)j * NTOK + m0 + t] = sq; }
  } else if (nt < NT_LAST) {
    bf16_t* gm = (bf16_t*)p.out;
    _Pragma("nounroll") for (int it = 0; it < 128 / NW; ++it) { const int row = it * NW + w; const long tok = m0 + row;
      *(unsigned*)(gm + tok * (2 * D_MODEL) + (nt - 26) * 128 + c) = pack2(fsigmoid(st[row * ST_LD + c]), fsigmoid(st[row * ST_LD + c + 1])); }
  } else {
    float* kr = WSP(float, kr); float* gn = WSP(float, gn); const float* ropeM = WSP(const float, ropeM);
    _Pragma("nounroll") for (int it = 0; it < 128 / NW; ++it) { const int row = it * NW + w; const long tok = m0 + row;
      if (l < 32) { const int i = l & 15; const float cs = ropeM[tok * 32 + i], sn = ropeM[tok * 32 + 16 + i]; const float x1 = st[row * ST_LD + i], x2 = st[row * ST_LD + 16 + i];
        kr[tok * 32 + l] = (l < 16) ? x1 * cs - x2 * sn : x2 * cs + x1 * sn; }
      if (l < 48) gn[tok * 48 + l] = fsigmoid(st[row * ST_LD + 32 + l]); }
  }
}

DI void epi_cmp1(const Params& p, const float* st, int m0, int n0, int which) {
  const int t = tid(), w = t >> 6, l = t & 63, c = 2 * l;
  const float* bias = WSP(const float, cmpbias) + which * CMP_HIDDEN; bf16_t* hid = WSP(bf16_t, hid) + (size_t)which * BATCH * NG * NCP * CMP_HIDDEN;
  const float b0 = bias[n0 + c], b1 = bias[n0 + c + 1];
  _Pragma("nounroll") for (int it = 0; it < 128 / NW; ++it) { const int row = it * NW + w;
    *(unsigned*)(hid + (long)(m0 + row) * CMP_HIDDEN + n0 + c) = pack2(fgelu_tanh(st[row * ST_LD + c] + b0), fgelu_tanh(st[row * ST_LD + c + 1] + b1)); }
}
DI void epi_cmp2(const Params& p, const float* st, int m0, int which) {
  const int t = tid(), w = t >> 6, l = t & 63;
  if (which == 0) { bf16_t* Kc = WSP(bf16_t, Kc); const int c = 2 * l;
    if (l < 32) _Pragma("nounroll") for (int it = 0; it < 128 / NW; ++it) { const int row = it * NW + w; const int m = m0 + row; const bool bad = (m % NCP) == NCP - 1;
      *(unsigned*)(Kc + (long)m * 64 + c) = bad ? 0u : pack2(st[row * ST_LD + c], st[row * ST_LD + c + 1]); }
  } else { bf16_t* VcT = WSP(bf16_t, VcT);
    _Pragma("nounroll") for (int it = 0; it < 64 / NW; ++it) { const int d = it * NW + w;
      for (int half = 0; half < 2; ++half) { const int row = 2 * l + half; const int m = m0 + row; const int bg = m / NCP, n = m % NCP; const bool bad = n == NCP - 1;
        VcT[((long)bg * 64 + d) * NCP + n] = bad ? (bf16_t)0 : f2bf(st[row * ST_LD + d]); } }
  }
}
DI float row_rstd(const float* part, int nparts, long tok, int dim) { float s = 0.f; for (int j = 0; j < nparts; ++j) s += part[(long)j * NTOK + tok]; return frsq(s / (float)dim + NORM_EPS); }

constexpr int RS_OFF = 131072;
DI void tile_rstd(const float* part, int nparts, int m0, int dim, char* lds) { const int t = tid(); __syncthreads();
  if (t < 256) ((float*)(lds + RS_OFF))[t] = row_rstd(part, nparts, m0 + t, dim); }
DI void epi_qup(const Params& p, const float* st, int m0, int n0) {
  const int t = tid(), w = t >> 6, l = t & 63, c = 2 * l;
  bf16_t* Qm = WSP(bf16_t, Qm); const float* ropeM = WSP(const float, ropeM); const float* part = WSP(const float, cqpart);
  const int col = n0 + c, dd = col % MQK;
  const float* rsl = (const float*)((const char*)st + RS_OFF) + (m0 & 255);
  _Pragma("nounroll") for (int it = 0; it < 128 / NW; ++it) { const int row = it * NW + w; const long tok = m0 + row; const float rs = rsl[row];
    float v0 = st[row * ST_LD + c], v1 = st[row * ST_LD + c + 1];
    if (dd >= 64) { const int i = dd - 64; const float* rt = ropeM + tok * 32;
      if (i < 16) { const float p0 = st[row * ST_LD + c + 16], p1 = st[row * ST_LD + c + 17]; v0 = v0 * rt[i] - p0 * rt[16 + i]; v1 = v1 * rt[i + 1] - p1 * rt[16 + i + 1]; }
      else { const int k = i - 16; const float p0 = st[row * ST_LD + c - 16], p1 = st[row * ST_LD + c - 15]; v0 = v0 * rt[k] + p0 * rt[16 + k]; v1 = v1 * rt[k + 1] + p1 * rt[16 + k + 1]; } }
    *(unsigned*)(Qm + tok * (NH * MQK) + col) = pack2(v0 * rs, v1 * rs); }
}
DI void epi_kvup(const Params& p, const float* st, int m0, int n0, char* lds) {
  const int t = tid(), w = t >> 6, l = t & 63, c = 2 * l;
  const int hd = n0 >> 7, b = m0 / SEQ, t0 = m0 % SEQ;
  bf16_t* Km = WSP(bf16_t, Km); bf16_t* VmT = WSP(bf16_t, VmT); const float* kr = WSP(const float, kr); const float* part = WSP(const float, ckvpart);
  const float* rsl = (const float*)(lds + RS_OFF) + (m0 & 255);
  { const int row = t >> 2, i = (t & 3) * 8; const float* src = kr + (long)(m0 + row) * 32 + i; const f32x4 x0 = *(const f32x4*)src, x1 = *(const f32x4*)(src + 4);
    *(u32x4*)(Km + ((long)(b * NH + hd) * SEQ + t0 + row) * MQK + 64 + i) = (u32x4){pack2(x0[0], x0[1]), pack2(x0[2], x0[3]), pack2(x1[0], x1[1]), pack2(x1[2], x1[3])}; }
  _Pragma("nounroll") for (int it = 0; it < 64 / NW; ++it) { const int row = (it * NW + w) * 2 + (l >> 5), ck = 2 * (l & 31); const float rs = rsl[row];
    bf16_t* dst = Km + ((long)(b * NH + hd) * SEQ + t0 + row) * MQK;
    *(unsigned*)(dst + ck) = pack2(st[row * ST_LD + ck] * rs, st[row * ST_LD + ck + 1] * rs); }
  _Pragma("nounroll") for (int it = 0; it < 64 / NW; ++it) { const int d = it * NW + w; const int col = 64 + d;
    *(unsigned*)(VmT + ((long)((b * NH + hd) * 64 + d) * SEQ + t0 + 2 * l)) = pack2(st[(2 * l) * ST_LD + col] * rsl[2 * l], st[(2 * l + 1) * ST_LD + col] * rsl[2 * l + 1]); }
}
DI void epi_merge(const Params& p, const float* st, int m0, int n0, int which) {
  const int t = tid(), w = t >> 6, l = t & 63, c = 2 * l;
  bf16_t* mg = WSP(bf16_t, merged); const bf16_t* gm = (const bf16_t*)p.out;
  _Pragma("nounroll") for (int it = 0; it < 128 / NW; ++it) { const int row = it * NW + w; const long tok = m0 + row;
    const unsigned g = *(const unsigned*)(gm + tok * (2 * D_MODEL) + which * D_MODEL + n0 + c);
    float v0 = bflo(g) * st[row * ST_LD + c], v1 = bfhi(g) * st[row * ST_LD + c + 1];
    unsigned* dst = (unsigned*)(mg + tok * D_MODEL + n0 + c);
    if (which == 1) { const unsigned prev = *dst; v0 += bflo(prev); v1 += bfhi(prev); }
    *dst = pack2(v0, v1); }
}
DI void epi_wout(const Params& p, const float* st, int m0, int n0) {
  const int t = tid(), w = t >> 6, l = t & 63, c = 2 * l;
  bf16_t* y = WSP(bf16_t, y);
  _Pragma("nounroll") for (int it = 0; it < 128 / NW; ++it) { const int row = it * NW + w; const long tok = m0 + row;
    *(unsigned*)(y + tok * D_MODEL + n0 + c) = pack2(st[row * ST_LD + c], st[row * ST_LD + c + 1]); }
}
DI void epi_pq(const Params& p, const float* st, int m0, int n0) {
  const int t = tid(), w = t >> 6, l = t & 63, c = 2 * l; bf16_t* q = WSP(bf16_t, qry);
  _Pragma("nounroll") for (int it = 0; it < 128 / NW; ++it) { const int row = it * NW + w; *(unsigned*)(q + (long)(m0 + row) * 2048 + n0 + c) = pack2(st[row * ST_LD + c], st[row * ST_LD + c + 1]); }
}
DI void epi_sc(const Params& p, const float* st, int m0, int n0) {
  const int t = tid(), w = t >> 6, l = t & 63, c = 2 * l; float* sc = WSP(float, sc);
  _Pragma("nounroll") for (int it = 0; it < 128 / NW; ++it) { const int row = it * NW + w; f32x2 v = {st[row * ST_LD + c], st[row * ST_LD + c + 1]}; *(f32x2*)(sc + (long)(m0 + row) * 2048 + n0 + c) = v; }
}

DI u32x2 pack4(const f32x4& v) { return (u32x2){pack2(v[0], v[1]), pack2(v[2], v[3])}; }
DI void epid_store_bf16(bf16_t* base, long ld, int row, int col, const f32x4& v0, const f32x4& v1) {
  bf16_t* dst = base + (long)row * ld + col; *(u32x2*)dst = pack4(v0); *(u32x2*)(dst + 16) = pack4(v1); }
DI void epid_qup(const Params& p, int row, int col, const f32x4& v0, const f32x4& v1, const char* lds) {
  const float rs = ((const float*)(lds + RS_OFF))[row & 255];
  f32x4 a = v0, b = v1;
  if ((col >> 5) % 3 == 2) { const float* rt = WSP(const float, ropeM) + (long)row * 32 + (col & 31); const f32x4 cs = *(const f32x4*)rt, sn = *(const f32x4*)(rt + 16);
    a = v0 * cs - v1 * sn; b = v1 * cs + v0 * sn; }
  epid_store_bf16(WSP(bf16_t, Qm), NH * MQK, row, col, a * rs, b * rs);
}
DI void epid_merge(const Params& p, int row, int col, const f32x4& v0, const f32x4& v1, int which) {
  bf16_t* mg = WSP(bf16_t, merged) + (long)row * D_MODEL + col; const bf16_t* gm = (const bf16_t*)p.out + (long)row * (2 * D_MODEL) + which * D_MODEL + col;
#pragma unroll
  for (int h = 0; h < 2; ++h) { const f32x4& v = h ? v1 : v0; const u32x2 g = *(const u32x2*)(gm + 16 * h);
    f32x4 r = {bflo(g[0]) * v[0], bfhi(g[0]) * v[1], bflo(g[1]) * v[2], bfhi(g[1]) * v[3]};
    if (which == 1) { const u32x2 pr = *(const u32x2*)(mg + 16 * h); r[0] += bflo(pr[0]); r[1] += bfhi(pr[0]); r[2] += bflo(pr[1]); r[3] += bfhi(pr[1]); }
    *(u32x2*)(mg + 16 * h) = pack4(r); } }
DI void epid_proj(const Params& p, int row, int col, const f32x4& v0, const f32x4& v1, int n0) {
  const int nt = n0 >> 7;
  if (nt < 26) {
    const bool isq = nt < 24; const int j = isq ? nt - 20 : nt - 24; const int ld = isq ? QR : KVR;
    epid_store_bf16(isq ? WSP(bf16_t, cq) : WSP(bf16_t, ckv), ld, row, j * 128 + col, v0, v1);
    float sq = v0[0] * v0[0] + v0[1] * v0[1] + v0[2] * v0[2] + v0[3] * v0[3] + v1[0] * v1[0] + v1[1] * v1[1] + v1[2] * v1[2] + v1[3] * v1[3];
    sq += __shfl_xor(sq, 16); sq += __shfl_xor(sq, 32);
    if ((tid() & 63) < 16) (isq ? WSP(float, cqpart) : WSP(float, ckvpart))[(long)(j * 4 + (col >> 5)) * NTOK + row] = sq;
  } else {
    bf16_t* gm = (bf16_t*)p.out + (long)row * (2 * D_MODEL) + (nt - 26) * 128 + col;
    const f32x4 s0 = {fsigmoid(v0[0]), fsigmoid(v0[1]), fsigmoid(v0[2]), fsigmoid(v0[3])}, s1 = {fsigmoid(v1[0]), fsigmoid(v1[1]), fsigmoid(v1[2]), fsigmoid(v1[3])};
    *(u32x2*)gm = pack4(s0); *(u32x2*)(gm + 16) = pack4(s1); }
}
DI void epid_cmp1(const Params& p, int row, int col, const f32x4& v0, const f32x4& v1, int which) {
  const float* bias = WSP(const float, cmpbias) + which * CMP_HIDDEN + col; bf16_t* hid = WSP(bf16_t, hid) + (size_t)which * BATCH * NG * NCP * CMP_HIDDEN + (long)row * CMP_HIDDEN + col;
  const f32x4 b0 = *(const f32x4*)bias, b1 = *(const f32x4*)(bias + 16);
  const f32x4 r0 = {fgelu_tanh(v0[0] + b0[0]), fgelu_tanh(v0[1] + b0[1]), fgelu_tanh(v0[2] + b0[2]), fgelu_tanh(v0[3] + b0[3])}, r1 = {fgelu_tanh(v1[0] + b1[0]), fgelu_tanh(v1[1] + b1[1]), fgelu_tanh(v1[2] + b1[2]), fgelu_tanh(v1[3] + b1[3])};
  *(u32x2*)hid = pack4(r0); *(u32x2*)(hid + 16) = pack4(r1); }

template <int DV> struct FlashAcc { f32x16 o[DV / 32]; float m, l; };
template <int DV> DI void flash_init(FlashAcc<DV>& a) { for (int i = 0; i < DV / 32; ++i) a.o[i] = zero16(); a.m = -1e30f; a.l = 0.f; }

template <int DQK> DI void load_q(bf16x8 (&qf)[DQK / 16], const bf16_t* qrow, int lh) {
#pragma unroll
  for (int kk = 0; kk < DQK / 16; ++kk) qf[kk] = *(const bf16x8*)(qrow + kk * 16 + lh * 8);
}

template <int DQK, int DV, class MaskF>
DI void flash_run(const bf16x8 (&qf)[DQK / 16], const bf16_t* Kp, long ldk, const bf16_t* Vp, const bf16_t* V2p, long ldv, int kt0, int kt1,
                  float scl, MaskF mask, FlashAcc<DV>& A, char* lds) {
  constexpr int KSTR = DQK * 2 + 16, VSTR = 136, KCH = DQK / 8;
  constexpr int KB = 64 * KSTR, VB = DV * VSTR;
  constexpr int NKCH = 64 * KCH, NVCH = DV * 8, NKC = (NKCH + NTHREADS - 1) / NTHREADS, NVC = (NVCH + NTHREADS - 1) / NTHREADS;
  const int t = tid(), l = t & 63, lr = l & 31, lh = l >> 5;
  char* const kb0 = lds; char* const kb1 = lds + KB; char* const vb0 = lds + 2 * KB; char* const vb1 = lds + 2 * KB + VB;
  u32x4 rk[NKC], rv[NVC], rk2[NKC], rv2[NVC];
  auto gload = [&](int kt, u32x4 (&rk_)[NKC], u32x4 (&rv_)[NVC]) __attribute__((always_inline)) { const int ktc = kt < kt1 ? kt : kt1 - 1;
#pragma unroll
    for (int i = 0; i < NKC; ++i) { const int cidx = t + NTHREADS * i, row = cidx / KCH, kc = cidx % KCH; if (NKCH % NTHREADS == 0 || cidx < NKCH) rk_[i] = GLD16(Kp + (long)(ktc * 64 + row) * ldk + kc * 8); }
#pragma unroll
    for (int i = 0; i < NVC; ++i) { const int cidx = t + NTHREADS * i, d = cidx >> 3, kc = cidx & 7; const bf16_t* src = (DV > 64 && d >= 64) ? (V2p + (long)(d - 64) * ldv) : (Vp + (long)d * ldv); if (NVCH % NTHREADS == 0 || cidx < NVCH) rv_[i] = GLD16(src + ktc * 64 + kc * 8); }
  };
  auto lwrite = [&](int buf) __attribute__((always_inline)) { char* const kbw = buf ? kb1 : kb0; char* const vbw = buf ? vb1 : vb0;
#pragma unroll
    for (int i = 0; i < NKC; ++i) { const int cidx = t + NTHREADS * i, row = cidx / KCH, kc = cidx % KCH; if (NKCH % NTHREADS == 0 || cidx < NKCH) *(u32x4*)(kbw + row * KSTR + kc * 16) = rk[i]; }
#pragma unroll
    for (int i = 0; i < NVC; ++i) { const int cidx = t + NTHREADS * i, d = cidx >> 3, kc = cidx & 7; char* dst = vbw + d * VSTR + kc * 16;
      if (NVCH % NTHREADS == 0 || cidx < NVCH) { u32x2 lo = {rv[i][0], rv[i][1]}, hi = {rv[i][2], rv[i][3]}; *(u32x2*)dst = lo; *(u32x2*)(dst + 8) = hi; } }
  };
  if (kt0 >= kt1) return;
  gload(kt0, rk, rv); lwrite(0); gload(kt0 + 1, rk, rv); __syncthreads();
  for (int kt = kt0; kt < kt1; ++kt) {
    const int cur = (kt - kt0) & 1; const bool more = kt + 1 < kt1; const char* const kbc = cur ? kb1 : kb0; const char* const vbc = cur ? vb1 : vb0;
    gload(kt + 2, rk2, rv2);
    if (!mask.dead(kt)) {
    f32x16 s[2];
#pragma unroll
    for (int kbk = 0; kbk < 2; ++kbk) { s[kbk] = zero16();
#pragma unroll
      for (int kk = 0; kk < DQK / 16; ++kk) { bf16x8 a = *(const bf16x8*)(kbc + (kbk * 32 + lr) * KSTR + kk * 32 + lh * 16); s[kbk] = mfma32(a, qf[kk], s[kbk]); } }
    const bool tile_ok = mask.tile(kt);
    float mnew, alpha, rsum = 0.f;
    if (mask.interior(kt)) {
      float mr = -3e38f;
#pragma unroll
      for (int kbk = 0; kbk < 2; ++kbk)
#pragma unroll
        for (int i = 0; i < 16; i += 2) mr = fmaxf(fmaxf(mr, s[kbk][i]), s[kbk][i + 1]);
      mr = fmaxf(mr, __shfl_xor(mr, 32));
      const float sl = tile_ok ? scl : 0.f;
      const float mx = tile_ok ? mr * scl : -1e30f;
      mnew = fmaxf(A.m, mx); alpha = fexp2(A.m - mnew); A.m = mnew;
      const float nb = tile_ok ? -mnew : -2e30f;
#pragma unroll
      for (int kbk = 0; kbk < 2; ++kbk)
#pragma unroll
        for (int i = 0; i < 16; ++i) { const float pv = fexp2(__builtin_fmaf(s[kbk][i], sl, nb)); s[kbk][i] = pv; rsum += pv; }
    } else {
      const int hiL = tile_ok ? mask.hi(kt) : -1, loL = mask.lo(kt);
      float mx = -1e30f;
#pragma unroll
      for (int kbk = 0; kbk < 2; ++kbk)
#pragma unroll
        for (int i = 0; i < 16; ++i) { const int c = kbk * 32 + crow(i, lh); const bool ok = (c <= hiL) & (c > loL); const float v = ok ? s[kbk][i] * scl : -1e30f; s[kbk][i] = v; mx = fmaxf(mx, v); }
      mx = fmaxf(mx, __shfl_xor(mx, 32));
      mnew = fmaxf(A.m, mx); alpha = fexp2(A.m - mnew); A.m = mnew;
      const float msub = (mnew > -1e29f) ? mnew : 1e30f;
#pragma unroll
      for (int kbk = 0; kbk < 2; ++kbk)
#pragma unroll
        for (int i = 0; i < 16; ++i) { const float pv = fexp2(s[kbk][i] - msub); s[kbk][i] = pv; rsum += pv; }
    }
    rsum += __shfl_xor(rsum, 32);
    A.l = A.l * alpha + rsum;
#pragma unroll
    for (int db = 0; db < DV / 32; ++db) A.o[db] = A.o[db] * alpha;
#pragma unroll
    for (int kbk = 0; kbk < 2; ++kbk)
#pragma unroll
      for (int s2 = 0; s2 < 2; ++s2) {
        u32x4 pk; for (int j = 0; j < 4; ++j) pk[j] = pack2(s[kbk][8 * s2 + 2 * j], s[kbk][8 * s2 + 2 * j + 1]);
        const bf16x8 pf = __builtin_bit_cast(bf16x8, pk);
#pragma unroll
        for (int db = 0; db < DV / 32; ++db) {
          const char* vr = vbc + (db * 32 + lr) * VSTR + (kbk * 32 + 16 * s2 + 4 * lh) * 2;
          const u32x2 lo = *(const u32x2*)vr, hi = *(const u32x2*)(vr + 16);
          u32x4 vv = {lo[0], lo[1], hi[0], hi[1]};
          A.o[db] = mfma32(__builtin_bit_cast(bf16x8, vv), pf, A.o[db]);
        }
      }
    }
    if (more) lwrite(cur ^ 1);
#pragma unroll
    for (int i = 0; i < NKC; ++i) rk[i] = rk2[i];
#pragma unroll
    for (int i = 0; i < NVC; ++i) rv[i] = rv2[i];
    __syncthreads();
  }
}

struct MaskNsa { int tq, kmul, kadd, wlim; unsigned long long bits; int tqmin, tqmax;
  DI bool tile(int kt) const { return (bits >> kt) & 1ull; }
  DI bool interior(int kt) const { return ((kt * 64 + 63) * kmul + kadd <= tqmin) && (tqmax - kt * 64 < wlim); }
  DI bool dead(int kt) const { return ((kt * 64) * kmul + kadd > tqmax) || (tqmin - (kt * 64 + 63) >= wlim); }
  DI int hi(int kt) const { const int q = tq - kadd; return (q >= 0 ? q / kmul : -1) - kt * 64; }
  DI int lo(int kt) const { return tq - wlim - kt * 64; }
  DI bool ok(int key) const { return (key * kmul + kadd <= tq) && (tq - key < wlim); } };
struct MaskCausal { int tq, tqmin; DI bool tile(int) const { return true; } DI bool interior(int kt) const { return kt * 64 + 63 <= tqmin; } DI bool dead(int kt) const { return kt * 64 > tqmin + 31; }
  DI int hi(int kt) const { return tq - kt * 64; } DI int lo(int) const { return -(1 << 30); } DI bool ok(int key) const { return key <= tq; } };
#ifdef HOST_EMU
DI char* launder(char* p) { return p; }
#else
DI char* launder(char* p) { asm volatile("" : "+s"(p)); return p; }
#endif
DI void nsa_tile(const Params& pin, int b, int g, int t0, char* lds) {
  Params p = pin; p.ws = launder(p.ws);
  const int t = tid(), w = t >> 6, l = t & 63, lr = l & 31, lh = l >> 5;
  const int qh = w >> 2, hidx = g * 4 + (w & 3), tq = t0 + qh * 32 + lr; const long tok = (long)b * SEQ + tq;
  const float SCL = 0.125f * 1.4426950408889634f;
  bf16x8 qf[4]; load_q<64>(qf, WSP(const bf16_t, Qn) + tok * 1024 + hidx * 64, lh);
  const float* gn = WSP(const float, gn) + tok * 48 + hidx * 3;
  const float g_cmp = gn[0], g_sel = gn[1], g_win = gn[2];
  const long bg = (long)b * NG + g;
  float* imp4 = (float*)lds; float* ofl = (float*)(lds + 65536) + w * 2048 + l; unsigned long long* masks = (unsigned long long*)(lds + LDS_MAIN - 512);
  const int cmp_kt1 = ((t0 + 32) / 16 + 1 + 63) / 64;
  const int diag_kt1 = (t0 + 63) / 64 + 1;
  unsigned long long mymask = ~0ull;
#pragma nounroll
  for (int br = 0; br < 4; ++br) {
    const bf16_t *Kp, *Vp; long ldv; int kt0 = 0, kt1, kmul = 1, kadd = 0, wlim = 1 << 30; unsigned long long bits = ~0ull; float gate;
    if (br <= 1) { Kp = WSP(const bf16_t, Kc) + bg * NCP * 64; Vp = br == 0 ? WSP(const bf16_t, ovlT) : WSP(const bf16_t, VcT) + bg * 64 * NCP; ldv = NCP; kt1 = cmp_kt1; kmul = 16; kadd = 31; gate = g_cmp; }
    else if (br == 2) { Kp = WSP(const bf16_t, Ks) + bg * SEQ * 64; Vp = WSP(const bf16_t, VsT) + bg * 64 * SEQ; ldv = SEQ; kt1 = diag_kt1; bits = mymask; gate = g_sel; }
    else { Kp = WSP(const bf16_t, Kw) + bg * SEQ * 64; Vp = WSP(const bf16_t, VwT) + bg * 64 * SEQ; ldv = SEQ; const int lo = t0 - (WINDOW - 1); kt0 = lo > 0 ? lo / 64 : 0; kt1 = diag_kt1; wlim = WINDOW; gate = g_win; }
    FlashAcc<64> A; flash_init(A);
    flash_run<64, 64>(qf, Kp, 64, Vp, (const bf16_t*)nullptr, ldv, kt0, kt1, SCL, MaskNsa{tq, kmul, kadd, wlim, bits, t0 + qh * 32, t0 + qh * 32 + 31}, A, lds);
    const float inv = A.l > 0.f ? 1.0f / A.l : 0.f;
    if (br == 0) {
#pragma unroll
      for (int db = 0; db < 2; ++db)
#pragma unroll
        for (int i = 0; i < 16; ++i) imp4[(w * 32 + lr) * 64 + db * 32 + crow(i, lh)] = A.o[db][i] * inv;
      __syncthreads();
#pragma nounroll
      for (int qi = 0; qi < 8; ++qi) {
        const int q = w * 8 + qi, tt = t0 + q, tb = tt >> 6;
        const float* ib = imp4 + ((q >> 5) * 4 * 32 + (q & 31)) * 64 + l;
        float v = ib[0] + ib[32 * 64] + ib[2 * 32 * 64] + ib[3 * 32 * 64];
        const bool valid = (l * 64 <= tt) && (l < NSEL);
        const bool forced = (l == 0) || (l == tb) || (l == tb - 1);
        v = valid ? (v + (forced ? 1e4f : 0.f)) : -1e30f;
        const int ki = (int)((f2u(v) & ~63u) | (unsigned)(63 - l));
        int rank = 0;
#pragma unroll
        for (int j = 0; j < 64; ++j) { const int kj = bcast_i(ki, j); rank += (kj > ki) ? 1 : 0; }
        const unsigned long long mk = __ballot(rank < 16);
        if (l == 0) masks[q] = mk;
      }
      __syncthreads();
      mymask = masks[qh * 32 + lr];
      __syncthreads();
    } else {
      const float sc = inv * gate;
      if (br == 1) {
#pragma unroll
        for (int db = 0; db < 2; ++db)
#pragma unroll
          for (int i = 0; i < 16; ++i) ofl[(db * 16 + i) * 64] = A.o[db][i] * sc;
      } else if (br == 2) {
#pragma unroll
        for (int db = 0; db < 2; ++db)
#pragma unroll
          for (int i = 0; i < 16; ++i) ofl[(db * 16 + i) * 64] += A.o[db][i] * sc;
      } else {
        bf16_t* on = WSP(bf16_t, on) + tok * 1024 + hidx * 64;
#pragma unroll
        for (int db = 0; db < 2; ++db)
#pragma unroll
          for (int q4 = 0; q4 < 4; ++q4) { float v[4];
#pragma unroll
            for (int e = 0; e < 4; ++e) v[e] = ofl[(db * 16 + 4 * q4 + e) * 64] + A.o[db][4 * q4 + e] * sc;
            u32x2 pk = {pack2(v[0], v[1]), pack2(v[2], v[3])}; *(u32x2*)(on + db * 32 + 8 * q4 + 4 * lh) = pk; }
      }
    }
  }
}

DI void mla_tile(const Params& pin, int b, int hd, int t0, char* lds) {
  Params p = pin; p.ws = launder(p.ws);
  const int t = tid(), w = t >> 6, l = t & 63, lr = l & 31, lh = l >> 5;
  const int tq = t0 + w * 32 + lr; const long tok = (long)b * SEQ + tq;
  const float SCL = 0.10206207261596575f * 1.4426950408889634f;
  bf16x8 qf[6]; load_q<96>(qf, WSP(const bf16_t, Qm) + tok * (NH * MQK) + hd * MQK, lh);
  FlashAcc<64> A; flash_init(A);
  const long bh = (long)b * NH + hd;
  flash_run<96, 64>(qf, WSP(const bf16_t, Km) + bh * SEQ * MQK, MQK, WSP(const bf16_t, VmT) + bh * 64 * SEQ, (const bf16_t*)nullptr, SEQ, 0, (t0 + 255) / 64 + 1, SCL, MaskCausal{tq, t0 + w * 32}, A, lds);
  const float inv = A.l > 0.f ? 1.0f / A.l : 0.f;
  bf16_t* om = WSP(bf16_t, om) + tok * 1024 + hd * 64;
#pragma unroll
  for (int db = 0; db < 2; ++db)
#pragma unroll
    for (int q4 = 0; q4 < 4; ++q4) { u32x2 v = {pack2(A.o[db][4 * q4] * inv, A.o[db][4 * q4 + 1] * inv), pack2(A.o[db][4 * q4 + 2] * inv, A.o[db][4 * q4 + 3] * inv)}; *(u32x2*)(om + db * 32 + 8 * q4 + 4 * lh) = v; }
}

DI int proj_colmap(int j) {
  if (j < 2560) return j;
  if (j < PC_CKV) return 2608 + (j - PC_CQ);
  if (j < PC_GM) return 3120 + (j - PC_CKV);
  if (j < PC_KR) return 3408 + (j - PC_GM);
  if (j < PC_GN) return 3376 + (j - PC_KR);
  if (j < PC_GN + 48) return 2560 + (j - PC_GN);
  return -1;
}
constexpr int CVN = 4096 / NTHREADS;
DI void convT_load(const float* src, int N, const float* scale, bool projmap, int kt, int nt, float (&v)[CVN]) {
  const int t = tid();
#pragma unroll
  for (int i = 0; i < CVN; ++i) { const int idx = i * NTHREADS + t, kr = idx >> 6, nc = idx & 63; const int n = nt * 64 + nc; const int col = projmap ? proj_colmap(n) : (n < N ? n : -1);
    float x = 0.f; if (col >= 0) { x = __builtin_nontemporal_load(src + (long)(kt * 64 + kr) * N + col); if (scale) x *= scale[kt * 64 + kr]; }
    v[i] = x; }
}
DI void convT_store(int K, bf16_t* dst, int kt, int nt, const float (&v)[CVN], char* lds) {
  float* tile = (float*)lds; const int t = tid();
  __syncthreads();
#pragma unroll
  for (int i = 0; i < CVN; ++i) { const int idx = i * NTHREADS + t, kr = idx >> 6, nc = idx & 63; tile[kr * 65 + nc] = v[i]; }
  __syncthreads();
#pragma unroll
  for (int i = 0; i < 2048 / NTHREADS; ++i) { const int idx = i * NTHREADS + t, n = idx >> 5, kp = idx & 31;
    *(unsigned*)(dst + (long)(nt * 64 + n) * K + kt * 64 + 2 * kp) = pack2(tile[(2 * kp) * 65 + n], tile[(2 * kp + 1) * 65 + n]); }
}
constexpr int CWN = 1024 / NTHREADS;
DI void convW_load(const float* src, int N, bool projmap, int kt, int nt4, f32x4 (&v)[4][CWN]) {
  const int t = tid();
#pragma unroll
  for (int j = 0; j < 4; ++j)
#pragma unroll
    for (int i = 0; i < CWN; ++i) { const int idx = i * NTHREADS + t, kr = idx >> 4, n4 = (idx & 15) * 4; const int n = (nt4 * 4 + j) * 64 + n4;
      f32x4 x = {0.f, 0.f, 0.f, 0.f};
      const int c0 = projmap ? proj_colmap(n) : (n < N ? n : -1), c3 = projmap ? proj_colmap(n + 3) : (n + 3 < N ? n + 3 : -1);
      const float* rowp = src + (long)(kt * 64 + kr) * N;
      if (c0 >= 0 && c3 == c0 + 3 && ((c0 & 3) == 0) && ((N & 3) == 0)) x = __builtin_nontemporal_load((const f32x4*)(rowp + c0));
      else { for (int e = 0; e < 4; ++e) { const int c = projmap ? proj_colmap(n + e) : (n + e < N ? n + e : -1); if (c >= 0) x[e] = rowp[c]; } }
      v[j][i] = x; }
}
DI void convW_store(int K, bf16_t* dst, int kt, int nt4, const f32x4 (&v)[4][CWN], char* lds) {
  float* tile = (float*)lds; const int t = tid();
  __syncthreads();
#pragma unroll
  for (int j = 0; j < 4; ++j)
#pragma unroll
    for (int i = 0; i < CWN; ++i) { const int idx = i * NTHREADS + t, kr = idx >> 4, n4 = (idx & 15) * 4;
#pragma unroll
      for (int e = 0; e < 4; ++e) tile[j * 4160 + kr * 65 + n4 + e] = v[j][i][e]; }
  __syncthreads();
#pragma unroll
  for (int j = 0; j < 4; ++j)
#pragma unroll
    for (int i = 0; i < 2048 / NTHREADS; ++i) { const int idx = i * NTHREADS + t, n = idx >> 5, kp = idx & 31;
      *(unsigned*)(dst + (long)((nt4 * 4 + j) * 64 + n) * K + kt * 64 + 2 * kp) = pack2(tile[j * 4160 + (2 * kp) * 65 + n], tile[j * 4160 + (2 * kp + 1) * 65 + n]); }
}
constexpr int TAB_TPR = D_MODEL / 8, TAB_RPP = NTHREADS / TAB_TPR, TAB_WPR = TAB_TPR >= 64 ? TAB_TPR / 64 : 1;
constexpr int TAB_N = NEXP / (4 * TAB_RPP);
DI void tab_items(const Params& p, char* lds, int first, int stride, int end) {
  const int t = tid(); float* red = (float*)lds;
  f32x4 a[4], bq[4], na[4], nb[4];
  auto tload = [&](int it_, f32x4 (&x)[4], f32x4 (&y)[4]) __attribute__((always_inline)) { const int ic = it_ < end ? it_ : first; const float* src = ic < TAB_N ? p.peer_u : p.peer_v; const int il = ic < TAB_N ? ic : ic - TAB_N;
#pragma unroll
    for (int u = 0; u < 4; ++u) { const long base = ((long)il * 4 + u) * (TAB_RPP * D_MODEL) + t * 8; x[u] = __builtin_nontemporal_load((const f32x4*)(src + base)); y[u] = __builtin_nontemporal_load((const f32x4*)(src + base + 4)); } };
  if (first < end) tload(first, a, bq);
  for (int item = first; item < end; item += stride) { tload(item + stride, na, nb);
    const bool isu = item < TAB_N; const int il = isu ? item : item - TAB_N;
    unsigned char* dst = isu ? WSP(unsigned char, U16) : WSP(unsigned char, V16); float* inv = isu ? WSP(float, uinv) : WSP(float, vinv);
    float mx[4];
#pragma unroll
    for (int u = 0; u < 4; ++u) { float m = 0.f;
#pragma unroll
      for (int e = 0; e < 4; ++e) m = fmaxf(m, fmaxf(fabsf(a[u][e]), fabsf(bq[u][e])));
      for (int sft = 32; sft >= 1; sft >>= 1) m = fmaxf(m, __shfl_xor(m, sft));
      mx[u] = m; }
    if (TAB_WPR > 1) { __syncthreads(); if ((t & 63) == 0) { for (int u = 0; u < 4; ++u) red[(t >> 6) * 4 + u] = mx[u]; } __syncthreads();
#pragma unroll
      for (int u = 0; u < 4; ++u) { float m = 0.f; const int w0 = (t / TAB_TPR) * TAB_WPR; for (int ww = 0; ww < TAB_WPR; ++ww) m = fmaxf(m, red[(w0 + ww) * 4 + u]); mx[u] = m; } }
#pragma unroll
    for (int u = 0; u < 4; ++u) { const long e = ((long)il * 4 + u) * TAB_RPP + t / TAB_TPR; const int col = (t % TAB_TPR) * 8; const float m = mx[u] > 0.f ? mx[u] : 1.f; const float sc = 440.0f / m;
      u32x2 o = {enc_fp8x4(a[u][0] * sc, a[u][1] * sc, a[u][2] * sc, a[u][3] * sc), enc_fp8x4(bq[u][0] * sc, bq[u][1] * sc, bq[u][2] * sc, bq[u][3] * sc)};
      *(u32x2*)(dst + ((long)(col >> 7) * NEXP + e) * 128 + (col & 127)) = o;
      if ((t % TAB_TPR) == 0) inv[e] = m * (1.0f / 440.0f); }
#pragma unroll
    for (int u = 0; u < 4; ++u) { a[u] = na[u]; bq[u] = nb[u]; } }
}
constexpr int LC_N0 = (1024 / 64) * (D_MODEL / 256), LC_N2 = (D_MODEL / 64) * (D_MODEL / 256), LC_N3 = (D_MODEL / 64) * (2048 / 256), LC_TOTAL = 2 * LC_N0 + LC_N2 + LC_N3;
DI void late_conv_items(const Params& p, char* lds, int first, int stride, int end) {
  auto job = [&](int it, const float*& src, int& K, int& N, bf16_t*& dst, int& kt, int& nt4) __attribute__((always_inline)) {
    int r = it;
    if (r < LC_N0) { src = p.w_branch_nsa; K = 1024; N = D_MODEL; dst = WSP(bf16_t, WnT); }
    else if ((r -= LC_N0) < LC_N0) { src = p.w_branch_mla; K = 1024; N = D_MODEL; dst = WSP(bf16_t, WmT); }
    else if ((r -= LC_N0) < LC_N2) { src = p.w_out; K = D_MODEL; N = D_MODEL; dst = WSP(bf16_t, WoT); }
    else { r -= LC_N2; src = p.peer_w_q; K = D_MODEL; N = 2048; dst = WSP(bf16_t, WpqT); }
    const int nkt = K / 64; kt = r % nkt; nt4 = r / nkt; };
  f32x4 cv[4][CWN], nv[4][CWN]; const float* src; int K, N, kt, nt4; bf16_t* dst;
  if (first < end) { job(first, src, K, N, dst, kt, nt4); convW_load(src, N, false, kt, nt4, cv); }
  for (int item = first; item < end; item += stride) { const int nx = item + stride < end ? item + stride : item;
    const float* s2; int K2, N2, kt2, nt2; bf16_t* d2; job(nx, s2, K2, N2, d2, kt2, nt2); convW_load(s2, N2, false, kt2, nt2, nv);
    job(item, src, K, N, dst, kt, nt4); convW_store(K, dst, kt, nt4, cv, lds);
#pragma unroll
    for (int j = 0; j < 4; ++j)
#pragma unroll
      for (int i = 0; i < CWN; ++i) cv[j][i] = nv[j][i]; }
}

DI void phase0(const Params& p, char* lds) {
  const int t = tid();
  int item = blockIdx.x;
  constexpr int N_ADA = 6 * D_MODEL / 64;
  for (; item < N_ADA; item += gridDim.x) {
    float* sc = (float*)lds;
    __syncthreads();
    for (int i = t; i < BATCH * D_MODEL; i += NTHREADS) { const float v = p.c[i]; sc[i] = v * fsigmoid(v); }
    __syncthreads();
    const int w = t >> 6, l = t & 63, cqd = l & 15, rs = l >> 4; const int n0 = item * 64 + cqd * 4;
    f32x4 acc[BATCH]; for (int b = 0; b < BATCH; ++b) acc[b] = (f32x4){0.f, 0.f, 0.f, 0.f};
    for (int j0 = 0; j0 < D_MODEL / (4 * NW); j0 += 8) { f32x4 wv[8];
#pragma unroll
      for (int u = 0; u < 8; ++u) { const int k = (j0 + u) * (4 * NW) + w * 4 + rs; wv[u] = __builtin_nontemporal_load((const f32x4*)(p.ada_w + (long)k * (6 * D_MODEL) + n0)); }
#pragma unroll
      for (int u = 0; u < 8; ++u) { const int k = (j0 + u) * (4 * NW) + w * 4 + rs;
#pragma unroll
        for (int b = 0; b < BATCH; ++b) acc[b] += wv[u] * sc[b * D_MODEL + k]; } }
    float* red = (float*)(lds + BATCH * D_MODEL * 4);
    for (int b = 0; b < BATCH; ++b) for (int e = 0; e < 4; ++e) { float v = acc[b][e]; v += __shfl_xor(v, 16); v += __shfl_xor(v, 32); if (rs == 0) red[(w * BATCH + b) * 64 + cqd * 4 + e] = v; }
    __syncthreads();
    if (t < 64 * BATCH) { const int b = t >> 6, cc = t & 63; float v = 0.f; for (int ww = 0; ww < NW; ++ww) v += red[(ww * BATCH + b) * 64 + cc];
      WSP(float, mod)[(long)b * 6 * D_MODEL + item * 64 + cc] = v + p.ada_b[item * 64 + cc]; }
  }
  item -= N_ADA;
  auto convjob = [&](const float* src, int K, int N, int Npad, bf16_t* dst, const float* scale, bool projmap) __attribute__((always_inline)) {
    const int nkt = K / 64, nnt = Npad / 64, n = nkt * nnt;
    float cv[CVN], nv[CVN];
    if (item < n) convT_load(src, N, scale, projmap, item % nkt, item / nkt, cv);
    for (; item < n; item += gridDim.x) { const int nx = item + (int)gridDim.x < n ? item + (int)gridDim.x : item;
      convT_load(src, N, scale, projmap, nx % nkt, nx / nkt, nv);
      convT_store(K, dst, item % nkt, item / nkt, cv, lds);
#pragma unroll
      for (int i = 0; i < CVN; ++i) cv[i] = nv[i]; }
    item -= n; };
  { const int nkt = D_MODEL / 64, n = nkt * (NPROJ / 256); f32x4 cv[4][CWN], nv[4][CWN];
    if (item < n) convW_load(p.w_in, IN_COLS, true, item % nkt, item / nkt, cv);
    for (; item < n; item += gridDim.x) { const int nx = item + (int)gridDim.x < n ? item + (int)gridDim.x : item;
      convW_load(p.w_in, IN_COLS, true, nx % nkt, nx / nkt, nv);
      convW_store(D_MODEL, WSP(bf16_t, WinT), item % nkt, item / nkt, cv, lds);
#pragma unroll
      for (int j = 0; j < 4; ++j)
#pragma unroll
        for (int i = 0; i < CWN; ++i) cv[j][i] = nv[j][i]; }
    item -= n; }
  convjob(p.cmp_w1, 2048, CMP_HIDDEN, CMP_HIDDEN, WSP(bf16_t, W1T), nullptr, false);
  convjob(p.cmp_w1 + (size_t)2048 * CMP_HIDDEN, 2048, CMP_HIDDEN, CMP_HIDDEN, WSP(bf16_t, W1T) + (size_t)CMP_HIDDEN * 2048, nullptr, false);
  convjob(p.cmp_w2, CMP_HIDDEN, 64, 128, WSP(bf16_t, W2T), nullptr, false);
  convjob(p.cmp_w2 + CMP_HIDDEN * 64, CMP_HIDDEN, 64, 128, WSP(bf16_t, W2T) + 128 * CMP_HIDDEN, nullptr, false);
  convjob(p.mla_w_q_up, QR, NH * MQK, NH * MQK, WSP(bf16_t, WquT), p.mla_q_norm_g, false);
  convjob(p.mla_w_kv_up, KVR, NH * 128, NH * 128, WSP(bf16_t, WkvT), p.mla_kv_norm_g, false);
  auto cvtjob = [&](const float* src, bf16_t* dst, long cnt) __attribute__((always_inline)) {
    const int n = (int)(cnt / (NTHREADS * 8));
    for (; item < n; item += gridDim.x) { const long base = (long)item * (NTHREADS * 8) + t * 8; const f32x4 a = *(const f32x4*)(src + base), bq = *(const f32x4*)(src + base + 4);
      u32x4 o = {pack2(a[0], a[1]), pack2(a[2], a[3]), pack2(bq[0], bq[1]), pack2(bq[2], bq[3])}; *(u32x4*)(dst + base) = o; }
    item -= n; };
  cvtjob(p.peer_sub_keys, WSP(bf16_t, SK), 16 * 128 * 128);
  { const int n = (NTOK + NTHREADS - 1) / NTHREADS;
    for (; item < n; item += gridDim.x) { const int tok = item * NTHREADS + t; if (tok < NTOK) { const float pf = (float)p.pos[tok];
        float* rn = WSP(float, ropeN) + (long)tok * 16; float* rm = WSP(float, ropeM) + (long)tok * 32;
        for (int i = 0; i < 8; ++i) { const float inv = fexp2(-(float)i * (2.0f / 16.0f) * 18.931568569324174f); const float ang = pf * inv; double r = (double)ang * 0.15915494309189535; r -= __builtin_rint(r); rn[i] = fcos_rev((float)r); rn[8 + i] = fsin_rev((float)r); }
        for (int i = 0; i < 16; ++i) { const float inv = fexp2(-(float)i * (2.0f / 32.0f) * 18.931568569324174f); const float ang = pf * inv; double r = (double)ang * 0.15915494309189535; r -= __builtin_rint(r); rm[i] = fcos_rev((float)r); rm[16 + i] = fsin_rev((float)r); } } }
    item -= n; }
  { const int n = 8;
    for (; item < n; item += gridDim.x) { const int which = item >> 2, j0 = (item & 3) * 64; const int w = t >> 6, l = t & 63;
      const float* pe = p.cmp_pe + which * 2048; const float* w1 = p.cmp_w1 + (size_t)which * 2048 * CMP_HIDDEN;
      float s = 0.f; for (int k = w; k < 2048; k += NW) s += pe[k] * w1[(long)k * CMP_HIDDEN + j0 + l];
      float* red = (float*)lds; __syncthreads(); red[w * 64 + l] = s; __syncthreads();
      if (t < 64) { float v = p.cmp_b1[which * CMP_HIDDEN + j0 + t]; for (int ww = 0; ww < NW; ++ww) v += red[ww * 64 + t]; WSP(float, cmpbias)[which * CMP_HIDDEN + j0 + t] = v; } }
    item -= n; }
  { const int n = 1;
    for (; item < n; item += gridDim.x) { bf16_t* o = WSP(bf16_t, ovlT); for (int i = t; i < 64 * NCP + 2048; i += NTHREADS) { const int s = i / NCP, nn = i % NCP; o[i] = (s < 64 && nn >= 4 * s - 1 && nn <= 4 * s + 3) ? (bf16_t)0x3f80 : (bf16_t)0; } }
    item -= n; }
}

constexpr int RV = D_MODEL / 256;
DI void phase_prenorm(const Params& p) {
  const int t_ = tid(); const int w = t_ >> 6, l = t_ & 63; const float* mod = WSP(const float, mod); bf16_t* h = WSP(bf16_t, h);
  for (long row = (long)blockIdx.x * NW + w; row < NTOK; row += (long)gridDim.x * NW) { const int b = (int)(row / SEQ);
    f32x4 xv[RV]; float ss = 0.f;
    for (int i = 0; i < RV; ++i) { xv[i] = *(const f32x4*)(p.x + row * D_MODEL + (i * 64 + l) * 4); ss += xv[i][0] * xv[i][0] + xv[i][1] * xv[i][1] + xv[i][2] * xv[i][2] + xv[i][3] * xv[i][3]; }
    const float rs = frsq(wave_sum(ss) / (float)D_MODEL + NORM_EPS);
    for (int i = 0; i < RV; ++i) { const int c0 = (i * 64 + l) * 4; const f32x4 g = *(const f32x4*)(p.attn_pre_g + c0), sh = *(const f32x4*)(mod + (long)b * 6 * D_MODEL + c0), sc = *(const f32x4*)(mod + (long)b * 6 * D_MODEL + D_MODEL + c0);
      f32x4 v = xv[i] * rs * g * (sc + 1.0f) + sh; u32x2 o = {pack2(v[0], v[1]), pack2(v[2], v[3])}; *(u32x2*)(h + row * D_MODEL + c0) = o; } }
}
DI void phase_postattn(const Params& p) {
  const int t_ = tid(); const int w = t_ >> 6, l = t_ & 63; const float* mod = WSP(const float, mod); bf16_t* h2 = WSP(bf16_t, h2); const bf16_t* y = WSP(const bf16_t, y);
  for (long row = (long)blockIdx.x * NW + w; row < NTOK; row += (long)gridDim.x * NW) { const int b = (int)(row / SEQ); const float* mb = mod + (long)b * 6 * D_MODEL;
    f32x4 xv[RV], yq[RV]; float ss = 0.f, sy = 0.f;
#pragma unroll
    for (int i = 0; i < RV; ++i) { const int c0 = (i * 64 + l) * 4; const u32x2 yy = *(const u32x2*)(y + row * D_MODEL + c0); yq[i] = (f32x4){bflo(yy[0]), bfhi(yy[0]), bflo(yy[1]), bfhi(yy[1])};
      sy += yq[i][0] * yq[i][0] + yq[i][1] * yq[i][1] + yq[i][2] * yq[i][2] + yq[i][3] * yq[i][3]; }
    const float rsy = frsq(wave_sum(sy) / (float)D_MODEL + NORM_EPS);
#pragma unroll
    for (int i = 0; i < RV; ++i) { const int c0 = (i * 64 + l) * 4; const f32x4 yv = yq[i];
      const f32x4 g = *(const f32x4*)(p.attn_post_g + c0), ga = *(const f32x4*)(mb + 2 * D_MODEL + c0);
      xv[i] = *(const f32x4*)(p.x + row * D_MODEL + c0) + ga * (yv * rsy * g);
      *(f32x4*)(p.out + row * D_MODEL + c0) = xv[i];
      ss += xv[i][0] * xv[i][0] + xv[i][1] * xv[i][1] + xv[i][2] * xv[i][2] + xv[i][3] * xv[i][3]; }
    const float rs = frsq(wave_sum(ss) / (float)D_MODEL + NORM_EPS);
    for (int i = 0; i < RV; ++i) { const int c0 = (i * 64 + l) * 4; const f32x4 g = *(const f32x4*)(p.ffn_pre_g + c0), sh = *(const f32x4*)(mb + 3 * D_MODEL + c0), sc = *(const f32x4*)(mb + 4 * D_MODEL + c0);
      f32x4 v = xv[i] * rs * g * (sc + 1.0f) + sh; u32x2 o = {pack2(v[0], v[1]), pack2(v[2], v[3])}; *(u32x2*)(h2 + row * D_MODEL + c0) = o; } }
}

DI int okey(float v) { int k = (int)f2u(v); return k ^ ((k >> 31) & 0x7fffffff); }
#ifdef HOST_EMU
DI int permute_push(int dst_lane, int v) { return emu_ds_permute(dst_lane, v); }
#else
DI int permute_push(int dst_lane, int v) { return __builtin_amdgcn_ds_permute(dst_lane << 2, v); }
#endif
#ifdef HOST_EMU
DI int lanes_below(unsigned long long m) { return __builtin_popcountll(m & ((1ull << (tid() & 63)) - 1ull)); }
#else
DI int lanes_below(unsigned long long m) { return (int)__builtin_amdgcn_mbcnt_hi((unsigned)(m >> 32), __builtin_amdgcn_mbcnt_lo((unsigned)m, 0u)); }
#endif
DI void phase_peer_topk(const Params& p) {
  const int t_ = tid(); const int w = t_ >> 6, l = t_ & 63; const float* sc = WSP(const float, sc); unsigned* picks = WSP(unsigned, picks);
  int ci, cj;
  if (l < 16) { ci = 0; cj = l; } else if (l < 24) { ci = 1; cj = l - 16; } else if (l < 29) { ci = 2; cj = l - 24; } else if (l < 33) { ci = 3; cj = l - 29; }
  else if (l < 36) { ci = 4; cj = l - 33; } else if (l < 42) { ci = 5 + ((l - 36) >> 1); cj = (l - 36) & 1; } else { ci = 8 + (l - 42); cj = 0; }
  const bool cvalid = l < 50; if (!cvalid) { ci = 0; cj = 0; }
  for (long it = (long)blockIdx.x * NW + w; it < (long)NTOK * PH; it += (long)gridDim.x * NW) { const long tok = it / PH; const int hh = (int)(it % PH);
    float sv[2]; int si[2];
    float a0[2], a1[2]; int k0[2], k1[2]; unsigned u0[2], u1[2], T[2];
#pragma unroll
    for (int pp = 0; pp < 2; ++pp) { const float* s = sc + tok * 2048 + (hh * 2 + pp) * 128; a0[pp] = s[l]; a1[pp] = s[l + 64];
      k0[pp] = (okey(a0[pp]) & ~127) | (127 - l); k1[pp] = (okey(a1[pp]) & ~127) | (63 - l);
      u0[pp] = (unsigned)k0[pp] ^ 0x80000000u; u1[pp] = (unsigned)k1[pp] ^ 0x80000000u; T[pp] = 0u; }
#pragma unroll
    for (int bit = 31; bit >= 0; --bit) {
#pragma unroll
      for (int pp = 0; pp < 2; ++pp) { const unsigned cand = T[pp] | (1u << bit);
        const int cnt = __builtin_popcountll(__ballot(u0[pp] >= cand)) + __builtin_popcountll(__ballot(u1[pp] >= cand)); if (cnt >= 16) T[pp] = cand; } }
    int kq[2], vq[2], iq[2];
#pragma unroll
    for (int pp = 0; pp < 2; ++pp) {
      const bool s0 = u0[pp] >= T[pp], s1 = u1[pp] >= T[pp]; const unsigned long long m0 = __ballot(s0), m1 = __ballot(s1);
      const int c0 = s0 ? lanes_below(m0) : 63, c1 = s1 ? __builtin_popcountll(m0) + lanes_below(m1) : 63;
      kq[pp] = permute_push(c0, k0[pp]) | permute_push(c1, k1[pp]);
      vq[pp] = permute_push(c0, (int)f2u(a0[pp])) | permute_push(c1, (int)f2u(a1[pp]));
      iq[pp] = permute_push(c0, l) | permute_push(c1, l + 64); }
    int rk[2] = {0, 0};
#pragma unroll
    for (int j = 0; j < 16; ++j) { const int q0 = bcast_i(kq[0], j), q1 = bcast_i(kq[1], j); rk[0] += (q0 > kq[0]); rk[1] += (q1 > kq[1]); }
#pragma unroll
    for (int pp = 0; pp < 2; ++pp) { const int dq = l < 16 ? rk[pp] : 63; sv[pp] = u2f((unsigned)permute_push(dq, vq[pp])); si[pp] = permute_push(dq, iq[pp]); }
    const float cand = shfl_f(sv[0], ci) + shfl_f(sv[1], cj); const int flat = ci * 16 + cj;
    const int kc = cvalid ? ((okey(cand) & ~255) | (255 - flat)) : (int)0x80000000;
    int rc = 0;
#pragma unroll
    for (int j = 0; j < 64; ++j) { const int q = bcast_i(kc, j); rc += (q > kc); }
    const int dc = (cvalid && rc < 16) ? rc : 63;
    const float tv = u2f((unsigned)permute_push(dc, (int)f2u(cand))); const int tp = permute_push(dc, flat);
    const int e1 = shfl_i(si[0], (tp >> 4) & 15), e2 = shfl_i(si[1], tp & 15);
    const float mx = bcast_f(tv, 0); float e = (l < 16) ? fexp2((tv - mx) * 1.4426950408889634f) : 0.f;
    float sum = e; for (int m = 8; m >= 1; m >>= 1) sum += __shfl_xor(sum, m);
    if (l < 16) { unsigned* dst = picks + (tok * NPICK + hh * 16 + l) * 2; dst[0] = (unsigned)(e1 * PNK + e2); dst[1] = f2u(e / sum); } }
}

#ifdef HOST_EMU
#define PIN_ORDER(acc, nxt) do {} while (0)
#else
#define PIN_ORDER(acc, nxt) asm volatile("" : "+v"(acc), "+v"((nxt)[0]), "+v"((nxt)[1]), "+v"((nxt)[2]), "+v"((nxt)[3]))
#endif
#ifdef HOST_EMU
DI float xch1(float x) { return __shfl_xor(x, 1); }
DI float xch2(float x) { return __shfl_xor(x, 2); }
DI float xch7(float x) { return __shfl(x, (tid() & 63) ^ 7); }
DI float xch8(float x) { return __shfl_xor(x, 8); }
DI float xch16(float x) { return __shfl_xor(x, 16); }
DI float xch32(float x) { return __shfl_xor(x, 32); }
#else
DI float xch1(float x) { return u2f((unsigned)__builtin_amdgcn_update_dpp(0, (int)f2u(x), 0xB1, 0xF, 0xF, true)); }
DI float xch2(float x) { return u2f((unsigned)__builtin_amdgcn_update_dpp(0, (int)f2u(x), 0x4E, 0xF, 0xF, true)); }
DI float xch7(float x) { return u2f((unsigned)__builtin_amdgcn_update_dpp(0, (int)f2u(x), 0x141, 0xF, 0xF, true)); }
DI float xch8(float x) { return u2f((unsigned)__builtin_amdgcn_update_dpp(0, (int)f2u(x), 0x128, 0xF, 0xF, true)); }
DI float xch16(float x) { const u32x2 r = __builtin_amdgcn_permlane16_swap(f2u(x), f2u(x), false, false); return u2f((tid() & 16) ? r[0] : r[1]); }
DI float xch32(float x) { const u32x2 r = __builtin_amdgcn_permlane32_swap(f2u(x), f2u(x), false, false); return u2f((tid() & 32) ? r[0] : r[1]); }
#endif
constexpr int NSL = D_MODEL / 128;
struct SliceSched { int g, ngroups, bi, nb; };
DI SliceSched slice_sched() { SliceSched s; const int G = gridDim.x; s.ngroups = G < 8 ? G : 8; s.g = blockIdx.x % s.ngroups; s.bi = blockIdx.x / s.ngroups; s.nb = (G - s.g + s.ngroups - 1) / s.ngroups; return s; }

DI void phase_peer_u(const Params& p) {
  const int t_ = tid(); const int w = t_ >> 6, l = t_ & 63, c8 = l & 7, pg = l >> 3; const SliceSched ss = slice_sched();
  const bf16_t* h2 = WSP(const bf16_t, h2); const unsigned* picks = WSP(const unsigned, picks); bf16_t* apart = WSP(bf16_t, apart);
  const long tstep = (long)ss.nb * NW;
  for (int s = ss.g; s < NSL; s += ss.ngroups) {
    const unsigned char* U = WSP(const unsigned char, U16) + (long)s * NEXP * 128 + c8 * 16;
    auto ldmeta = [&](long tok, u32x2& pk, u32x4& hq0, u32x4& hq1) __attribute__((always_inline)) { const long tc = tok < NTOK ? tok : NTOK - 1;
      { const unsigned* pp = picks + ((unsigned)tc * (unsigned)NPICK + 2u * (unsigned)l) * 2u; pk[0] = pp[0]; pk[1] = pp[2]; } const bf16_t* hp = h2 + ((unsigned)tc * (unsigned)D_MODEL + (unsigned)(s * 128 + c8 * 16)); hq0 = *(const u32x4*)hp; hq1 = *(const u32x4*)(hp + 8); };
    auto issue = [&](const u32x2& pk, u32x4 (&uv)[16]) __attribute__((always_inline)) { const int ipair = (int)((pk[0] & 0xffffu) | (pk[1] << 16));
#pragma unroll
      for (int r2 = 0; r2 < 8; ++r2) { const unsigned pr = (unsigned)shfl_i(ipair, pg * 8 + r2);
        uv[2 * r2] = *(const u32x4*)(U + ((pr & 0xffffu) << 7)); uv[2 * r2 + 1] = *(const u32x4*)(U + ((pr >> 16) << 7)); } };
    auto reduce = [&](long tok, u32x4 (&uv)[16], const u32x4& hq0, const u32x4& hq1) __attribute__((always_inline)) {
      f32x2 hv[8];
#pragma unroll
      for (int q = 0; q < 4; ++q) { hv[q] = (f32x2){bflo(hq0[q]), bfhi(hq0[q])}; hv[4 + q] = (f32x2){bflo(hq1[q]), bfhi(hq1[q])}; }
      float d[16];
#pragma unroll
      for (int r = 0; r < 16; ++r) { f32x2 s2 = {0.f, 0.f};
#pragma unroll
        for (int q = 0; q < 4; ++q) { s2 = __builtin_elementwise_fma(dec_fp8_lo(uv[r][q]), hv[2 * q], s2); s2 = __builtin_elementwise_fma(dec_fp8_hi(uv[r][q]), hv[2 * q + 1], s2); }
        float sacc = s2[0] + s2[1];
        if (r + 1 < 16) PIN_ORDER(sacc, uv[r + 1 < 16 ? r + 1 : 15]);
        d[r] = sacc; }
      float d8[8], d4[4], d2[2];
#pragma unroll
      for (int k = 0; k < 8; ++k) { const bool hi = l & 4; const float keep = hi ? d[8 + k] : d[k], send = hi ? d[k] : d[8 + k]; d8[k] = keep + xch7(send); }
#pragma unroll
      for (int k = 0; k < 4; ++k) { const bool hi = l & 2; const float keep = hi ? d8[4 + k] : d8[k], send = hi ? d8[k] : d8[4 + k]; d4[k] = keep + xch2(send); }
#pragma unroll
      for (int k = 0; k < 2; ++k) { const bool hi = l & 1; const float keep = hi ? d4[2 + k] : d4[k], send = hi ? d4[k] : d4[2 + k]; d2[k] = keep + xch1(send); }
      const int r0 = ((l & 4) ? 8 : 0) + ((l & 2) ? 4 : 0) + ((l & 1) ? 2 : 0);
      if (tok < NTOK) *(unsigned*)(apart + (((unsigned)s * (unsigned)NTOK + (unsigned)tok) * (unsigned)NPICK + (unsigned)(pg * 16 + r0))) = pack2(d2[0], d2[1]); };
    long tok = (long)ss.bi * NW + w;
    u32x2 pkA, pkB; u32x4 hA0, hA1, hB0, hB1, uvA[16], uvB[16];
    ldmeta(tok, pkA, hA0, hA1); issue(pkA, uvA); ldmeta(tok + tstep, pkB, hB0, hB1);
    for (; tok < NTOK; tok += 2 * tstep) {
      u32x2 pkC; u32x4 hC0, hC1;
      issue(pkB, uvB); ldmeta(tok + 2 * tstep, pkC, hC0, hC1);
      reduce(tok, uvA, hA0, hA1);
      issue(pkC, uvA); ldmeta(tok + 3 * tstep, pkB, hA0, hA1);
      reduce(tok + tstep, uvB, hB0, hB1);
      const u32x4 t0 = hA0, t1 = hA1; hA0 = hC0; hA1 = hC1; hB0 = t0; hB1 = t1;
    }
  }
}
DI void phase_peer_w(const Params& p) {
  const unsigned* picks = WSP(const unsigned, picks); const bf16_t* apart = WSP(const bf16_t, apart); unsigned* pw = WSP(unsigned, pw);
  const float* uinv = WSP(const float, uinv); const float* vinv = WSP(const float, vinv);
  for (long i = (long)blockIdx.x * NTHREADS + tid(); i < (long)NTOK * NPICK; i += (long)gridDim.x * NTHREADS) {
    float a = 0.f;
#pragma unroll 8
    for (int s = 0; s < NSL; ++s) a += bf2f(apart[(long)s * NTOK * NPICK + i]);
    const unsigned idx = picks[i * 2]; const float gate = u2f(picks[i * 2 + 1]);
    a *= uinv[idx];
    pw[i] = (idx & 0xffffu) | (pack2(0.f, fgelu_tanh(a) * gate * vinv[idx]) & 0xffff0000u);
  }
}
DI void phase_peer_v(const Params& p) {
  const int t_ = tid(); const int w = t_ >> 6, l = t_ & 63, c8 = l & 7, pg = l >> 3; const SliceSched ss = slice_sched();
  const unsigned* pw = WSP(const unsigned, pw); bf16_t* yb = WSP(bf16_t, yb); float* ypart2 = WSP(float, ypart2);
  const long tstep = (long)ss.nb * NW;
  for (int s = ss.g; s < NSL; s += ss.ngroups) {
    const unsigned char* V = WSP(const unsigned char, V16) + (long)s * NEXP * 128 + c8 * 16;
    auto ldmeta = [&](long tok, u32x2& pq) __attribute__((always_inline)) { const unsigned tc = (unsigned)(tok < NTOK ? tok : NTOK - 1); pq = *(const u32x2*)(pw + (tc * (unsigned)NPICK + 2u * (unsigned)l)); };
    auto issue_half = [&](const u32x2& pq, int half, u32x4 (&vv)[8], unsigned (&wg)[4]) __attribute__((always_inline)) { const int p0 = (int)pq[0], p1 = (int)pq[1];
#pragma unroll
      for (int q = 0; q < 4; ++q) { const int r2 = half * 4 + q; const unsigned re = (unsigned)shfl_i(p0, pg * 8 + r2), ro = (unsigned)shfl_i(p1, pg * 8 + r2); wg[q] = (re >> 16) | (ro & 0xffff0000u);
        vv[2 * q] = *(const u32x4*)(V + ((re & 0xffffu) << 7)); vv[2 * q + 1] = *(const u32x4*)(V + ((ro & 0xffffu) << 7)); } };
    auto acc_half = [&](u32x4 (&vv)[8], unsigned (&wg)[4], f32x2 (&acc)[8]) __attribute__((always_inline)) {
#pragma unroll
      for (int r = 0; r < 8; ++r) { const float wr_ = (r & 1) ? bfhi(wg[r >> 1]) : bflo(wg[r >> 1]); const f32x2 w2 = {wr_, wr_};
#pragma unroll
        for (int q = 0; q < 4; ++q) { acc[2 * q] = __builtin_elementwise_fma(dec_fp8_lo(vv[r][q]), w2, acc[2 * q]); acc[2 * q + 1] = __builtin_elementwise_fma(dec_fp8_hi(vv[r][q]), w2, acc[2 * q + 1]); }
        if (r + 1 < 8) PIN_ORDER(acc[0], vv[r + 1 < 8 ? r + 1 : 7]); } };
    auto finish = [&](long tok, f32x2 (&acc2)[8]) __attribute__((always_inline)) { float acc[16];
#pragma unroll
      for (int j = 0; j < 8; ++j) { acc[2 * j] = acc2[j][0]; acc[2 * j + 1] = acc2[j][1]; }
      float a8[8], a4[4], a2[2];
#pragma unroll
      for (int k = 0; k < 8; ++k) { const bool hi = l & 32; const float keep = hi ? acc[8 + k] : acc[k], send = hi ? acc[k] : acc[8 + k]; a8[k] = keep + xch32(send); }
#pragma unroll
      for (int k = 0; k < 4; ++k) { const bool hi = l & 16; const float keep = hi ? a8[4 + k] : a8[k], send = hi ? a8[k] : a8[4 + k]; a4[k] = keep + xch16(send); }
#pragma unroll
      for (int k = 0; k < 2; ++k) { const bool hi = l & 8; const float keep = hi ? a4[2 + k] : a4[k], send = hi ? a4[k] : a4[2 + k]; a2[k] = keep + xch8(send); }
      const int col = c8 * 16 + ((l & 32) ? 8 : 0) + ((l & 16) ? 4 : 0) + ((l & 8) ? 2 : 0);
      const float sq = wave_sum(a2[0] * a2[0] + a2[1] * a2[1]);
      if (tok < NTOK) { *(unsigned*)(yb + ((unsigned)tok * (unsigned)D_MODEL + (unsigned)(s * 128 + col))) = pack2(a2[0], a2[1]); if (l == 0) ypart2[(unsigned)s * (unsigned)NTOK + (unsigned)tok] = sq; } };
    long tok = (long)ss.bi * NW + w;
    u32x2 pqCur, pqNext; u32x4 vvA[8], vvB[8]; unsigned wgA[4], wgB[4];
    ldmeta(tok, pqCur); issue_half(pqCur, 0, vvA, wgA); ldmeta(tok + tstep, pqNext);
    for (; tok < NTOK; tok += tstep) {
      u32x2 pqN2; issue_half(pqCur, 1, vvB, wgB); ldmeta(tok + 2 * tstep, pqN2);
      f32x2 acc[8];
#pragma unroll
      for (int j = 0; j < 8; ++j) acc[j] = (f32x2){0.f, 0.f};
      acc_half(vvA, wgA, acc);
      issue_half(pqNext, 0, vvA, wgA);
      acc_half(vvB, wgB, acc);
      finish(tok, acc);
      pqCur = pqNext; pqNext = pqN2;
    }
  }
}
DI void phase_peer_final(const Params& p) {
  const int t_ = tid(); const int w = t_ >> 6, l = t_ & 63; const float* mod = WSP(const float, mod); const bf16_t* yb = WSP(const bf16_t, yb); const float* ypart2 = WSP(const float, ypart2);
  for (long row = (long)blockIdx.x * NW + w; row < NTOK; row += (long)gridDim.x * NW) { const int b = (int)(row / SEQ); const float* mb = mod + (long)b * 6 * D_MODEL + 5 * D_MODEL;
    const float rs = row_rstd(ypart2, NSL, row, D_MODEL);
#pragma unroll
    for (int i = 0; i < RV; ++i) { const int c0 = (i * 64 + l) * 4; const u32x2 yy = *(const u32x2*)(yb + row * D_MODEL + c0); const f32x4 yv = {bflo(yy[0]), bfhi(yy[0]), bflo(yy[1]), bfhi(yy[1])};
      float* op = p.out + row * D_MODEL + c0; const f32x4 g = *(const f32x4*)(p.ffn_post_g + c0), gf = *(const f32x4*)(mb + c0);
      *(f32x4*)op = *(const f32x4*)op + gf * (yv * rs * g); } }
}

#ifdef HOST_EMU
struct GridBar { int dummy; };
DI GridBar gridbar_init(const Params&, char*) { return GridBar{0}; }
DI void gsync(const GridBar&) { emu_grid_sync(); }
#else
#define XB_TMO      128
#define XB_XCNT(j)  (256  + 64 * (j))
#define XB_XSUB(j)  (1280 + 64 * (j))
#define XB_XGEN(j)  (2304 + 64 * (j))
#define XB_TOP      3328
#define XB_TOPGEN   3392
#define XCD_BAR_WORDS 3456
#define XB_SPIN_CAP (1u << 22)
DI unsigned xb_ld(unsigned* p) { return __hip_atomic_load(p, __ATOMIC_RELAXED, __HIP_MEMORY_SCOPE_AGENT); }
DI unsigned xb_add(unsigned* p, unsigned v) { return __hip_atomic_fetch_add(p, v, __ATOMIC_RELAXED, __HIP_MEMORY_SCOPE_AGENT); }
DI unsigned xb_xcc_id() { return (unsigned)__builtin_amdgcn_s_getreg((3 << 11) | 20) & 0xFu; }
#define XB_SPIN(cond, bar) do { unsigned _sp = 0; while (cond) { __builtin_amdgcn_s_sleep(1); \
    if ((++_sp & 255u) == 0u) { if (xb_ld(&(bar)[XB_TMO])) break; if (_sp > XB_SPIN_CAP) { atomicAdd(&(bar)[XB_TMO], 1u); break; } } } } while (0)
struct GridBar { unsigned* bar; unsigned x; volatile unsigned* st; };
DI GridBar gridbar_init(const Params& p, char* lds) {
  GridBar b; b.bar = (unsigned*)(p.ws + WL.bar); b.x = xb_xcc_id(); b.st = (volatile unsigned*)(lds + LDS_MAIN);
  if (threadIdx.x == 0) { b.st[0] = 0u; b.st[1] = 0u; (void)xb_add(&b.bar[XB_XCNT(b.x)], 1u); }
  __syncthreads();
  return b;
}
DI void xb_complete(unsigned* bar, unsigned x, unsigned& nloc, unsigned& nx) {
  const unsigned G = gridDim.x; unsigned sum, cnt, mine, sp = 0u;
  for (;;) { sum = 0u; cnt = 0u; mine = 0u;
#pragma unroll
    for (unsigned j = 0; j < 16; ++j) { const unsigned c = xb_ld(&bar[XB_XCNT(j)]); sum += c; cnt += (c > 0u) ? 1u : 0u; mine = (j == x) ? c : mine; }
    if (sum == G) break;
    __builtin_amdgcn_s_sleep(1);
    if ((++sp & 255u) == 0u) { if (xb_ld(&bar[XB_TMO])) break; if (sp > XB_SPIN_CAP) { atomicAdd(&bar[XB_TMO], 1u); break; } } }
  nloc = mine > 0u ? mine : 1u; nx = cnt > 0u ? cnt : 1u;
}
DI void gsync(const GridBar& b) {
  asm volatile("s_waitcnt vmcnt(0)" ::: "memory");
  __syncthreads();
  if (threadIdx.x == 0) {
    unsigned* bar = b.bar;
    __builtin_amdgcn_s_waitcnt(0);
    unsigned nloc = b.st[0], nx = b.st[1];
    if (nloc == 0u) { xb_complete(bar, b.x, nloc, nx); b.st[0] = nloc; b.st[1] = nx; }
    const unsigned old = xb_add(&bar[XB_XSUB(b.x)], 1u);
    const unsigned gen = old / nloc;
    if (old + 1u == (gen + 1u) * nloc) {
      __builtin_amdgcn_fence(__ATOMIC_RELEASE, "agent");
      asm volatile("s_waitcnt vmcnt(0)" ::: "memory");
      const unsigned og = xb_add(&bar[XB_TOP], 1u);
      const unsigned tg = og / nx;
      if (og + 1u == (tg + 1u) * nx) xb_add(&bar[XB_TOPGEN], 1u);
      else XB_SPIN(xb_ld(&bar[XB_TOPGEN]) == tg, bar);
      __builtin_amdgcn_fence(__ATOMIC_ACQUIRE, "agent");
      xb_add(&bar[XB_XGEN(b.x)], 1u);
      asm volatile("s_waitcnt vmcnt(0)" ::: "memory");
    } else {
      XB_SPIN(xb_ld(&bar[XB_XGEN(b.x)]) == gen, bar);
      __builtin_amdgcn_fence(__ATOMIC_ACQUIRE, "agent");
      asm volatile("s_waitcnt vmcnt(0)" ::: "memory");
    }
  }
  __syncthreads();
}
#endif

#ifdef HOST_EMU
#define PLOAD(parg) (parg)
#else
DI Params pload_kernarg() {
#if defined(__HIP_DEVICE_COMPILE__)
  const __attribute__((address_space(4))) Params* kp = (const __attribute__((address_space(4))) Params*)__builtin_amdgcn_kernarg_segment_ptr(); asm volatile("" : "+s"(kp)); return *kp;
#else
  return Params{};
#endif
}
#define PLOAD(parg) pload_kernarg()
#endif
#ifndef HOST_EMU
__global__ __launch_bounds__(NTHREADS, 2)
#endif
void fwd_kernel(Params p_arg) {
  char* lds = LDS_PTR();
  GridBar gb; { const Params p = PLOAD(p_arg); gb = gridbar_init(p, lds); }
  const int G = gridDim.x, bid = blockIdx.x;
  for (int rep = 0; rep < REPS(0); ++rep) if (PH_ON(0)) { const Params p = PLOAD(p_arg); phase0(p, lds); }
  grid_sync();
  for (int rep = 0; rep < REPS(1); ++rep) if (PH_ON(1)) { const Params p = PLOAD(p_arg); phase_prenorm(p); }
  gsync(gb);
  for (int rep = 0; rep < REPS(2); ++rep) if (PH_ON(2)) { const Params p = PLOAD(p_arg); const int nM = (NTOK + 255) / 256, nN = (NPROJ + 255) / 256;
    for (int tile = bid; tile < nM * nN; tile += G) { const int mt = tile % nM, nt = tile / nM;
      gemm_tile8(WSP(const bf16_t, h), D_MODEL, NTOK, mt * 256, WSP(const bf16_t, WinT) + (long)nt * 256 * D_MODEL, D_MODEL, NPROJ_VALID - nt * 256, D_MODEL, lds, [&](int hn) { const int q = (nt * 256 + hn * 128) >> 7; return q >= 20 && q < NT_LAST; },
                 [&](const float* st, int m0, int nq) { epi_proj(p, st, m0, nt * 256 + nq); }, [&](int row, int col, const f32x4& v0, const f32x4& v1, int nq) { epid_proj(p, row, col, v0, v1, nt * 256 + nq); }); }
    { const int ntl = nM * nN, rem = ntl % G, nlight = rem ? G - rem : 0; constexpr int KL = 22;
      int part = KL * nlight; if (part > 2 * TAB_N) part = 2 * TAB_N;
      if (nlight && bid >= rem) tab_items(p, lds, bid - rem, nlight, part);
      tab_items(p, lds, part + bid, G, 2 * TAB_N); } }
  gsync(gb);
  for (int rep = 0; rep < REPS(3); ++rep) if (PH_ON(3)) { const Params p = PLOAD(p_arg); constexpr int MC = BATCH * NG * NCP; const int nMc = (MC + 255) / 256, nc = 2 * nMc, nMt = (NTOK + 255) / 256, nq = nMt * (NH * MQK / 256), nkv = nMt * (NH / 2);
    const int hole = G > nc ? nc : 0;
    for (int j = 0;; ++j) { int tile;
      if (j < 2 || !hole) tile = j * G + bid; else { if (bid < hole) break; tile = 2 * G + (j - 2) * (G - hole) + (bid - hole); }
      if (tile >= nc + nq + nkv) break;
      if (tile < nc) { const int which = tile / nMc, mt = tile % nMc;
        gemm_tile8(which == 0 ? WSP(const bf16_t, KcR) : WSP(const bf16_t, VcR), 1024, MC, mt * 256, WSP(const bf16_t, W1T) + (long)which * CMP_HIDDEN * 2048, 2048, CMP_HIDDEN, 2048, lds,
                  [&](int) { return true; }, [&](const float* st, int m0, int nq_) { epi_cmp1(p, st, m0, nq_, which); }, [&](int row, int col, const f32x4& v0, const f32x4& v1, int nq_) { epid_cmp1(p, row, nq_ + col, v0, v1, which); });
#ifndef HOST_EMU
        __builtin_amdgcn_fence(__ATOMIC_RELEASE, "workgroup"); __syncthreads(); __builtin_amdgcn_fence(__ATOMIC_ACQUIRE, "workgroup");
#else
        __syncthreads();
#endif
        gemm_tile(WSP(const bf16_t, hid) + (long)which * MC * CMP_HIDDEN, CMP_HIDDEN, MC, mt * 256, WSP(const bf16_t, W2T) + (long)which * 128 * CMP_HIDDEN, CMP_HIDDEN, 128, CMP_HIDDEN, lds,
                  [&](const float* st, int m0, int) { epi_cmp2(p, st, m0, which); });
      } else if (tile < nc + nq) { const int r = tile - nc, mt = r % nMt, nt = r / nMt; tile_rstd(WSP(const float, cqpart), 16, mt * 256, QR, lds);
        gemm_tile8(WSP(const bf16_t, cq), QR, NTOK, mt * 256, WSP(const bf16_t, WquT) + (long)nt * 256 * QR, QR, 256, QR, lds, [&](int) { return false; }, [&](const float* st, int m0, int nq_) { epi_qup(p, st, m0, nt * 256 + nq_); }, [&](int, int, const f32x4&, const f32x4&, int) {});
      } else { const int r = tile - nc - nq, mt = r % nMt, nt = r / nMt; tile_rstd(WSP(const float, ckvpart), 8, mt * 256, KVR, lds);
        gemm_tile8(WSP(const bf16_t, ckv), KVR, NTOK, mt * 256, WSP(const bf16_t, WkvT) + (long)nt * 256 * KVR, KVR, 256, KVR, lds, [&](int) { return false; }, [&](const float* st, int m0, int nq_) { epi_kvup(p, st, m0, nt * 256 + nq_, lds); }, [&](int, int, const f32x4&, const f32x4&, int) {});
      } }
    late_conv_items(p, lds, bid, G, LC_TOTAL); }
  gsync(gb);
#ifdef HOST_EMU
  gsync(gb);
#endif
  for (int rep = 0; rep < REPS(5); ++rep) if (PH_ON(5)) { const Params p = PLOAD(p_arg); const int nN = BATCH * NG * (SEQ / 64), nMl = BATCH * NH * (SEQ / 256), total = nN + nMl;
    for (int j = 0;; ++j) { const long rank = (long)j * G + ((j & 1) ? (G - 1 - bid) : bid); if ((long)j * G >= total) break; if (rank >= total) continue;
      int isn, idx; const int pairs = nN < nMl ? nN : nMl;
      if (rank < 2 * pairs) { isn = (rank & 1) == 0; idx = (int)(rank >> 1); } else { isn = nN > nMl; idx = (int)(rank - pairs); }
#ifdef NO_NSA
      if (0) {}
#else
      if (isn) { const int ti = (SEQ / 64 - 1) - idx / (BATCH * NG), bgx = idx % (BATCH * NG); nsa_tile(p, bgx / NG, bgx % NG, ti * 64, lds); }
#endif
#ifndef NO_MLA
      else { const int ti = (SEQ / 256 - 1) - idx / (BATCH * NH), bh = idx % (BATCH * NH); mla_tile(p, bh / NH, bh % NH, ti * 256, lds); }
#endif
      __syncthreads(); } }
  gsync(gb);
  for (int rep = 0; rep < REPS(6); ++rep) if (PH_ON(6)) { const Params p = PLOAD(p_arg); const int nM = (NTOK + 255) / 256, nN = D_MODEL / 256;
    for (int tile = bid; tile < nM * nN; tile += G) { const int mt = tile % nM, nt = tile / nM;
      const bf16_t* gm = (const bf16_t*)p.out; bf16_t* mg = WSP(bf16_t, merged);
      gemm_tile8_merge(WSP(const bf16_t, on), WSP(const bf16_t, WnT) + (long)nt * 256 * 1024, WSP(const bf16_t, om), WSP(const bf16_t, WmT) + (long)nt * 256 * 1024, 1024, mt * 256, 1024, lds,
        [&](int row, int col, f32x4& g0, f32x4& g1) __attribute__((always_inline)) { const bf16_t* gp = gm + (long)row * (2 * D_MODEL) + nt * 256 + col; const u32x2 a = *(const u32x2*)gp, b = *(const u32x2*)(gp + D_MODEL);
          g0 = (f32x4){bflo(a[0]), bfhi(a[0]), bflo(a[1]), bfhi(a[1])}; g1 = (f32x4){bflo(b[0]), bfhi(b[0]), bflo(b[1]), bfhi(b[1])}; },
        [&](int row, int col, const f32x4& v) __attribute__((always_inline)) { *(u32x2*)(mg + (long)row * D_MODEL + nt * 256 + col) = pack4(v); }); } }
  gsync(gb);
  for (int rep = 0; rep < REPS(7); ++rep) if (PH_ON(7)) { const Params p = PLOAD(p_arg); const int nM = (NTOK + 255) / 256, nN = D_MODEL / 256;
    for (int tile = bid; tile < nM * nN; tile += G) { const int mt = tile % nM, nt = tile / nM;
      gemm_tile8(WSP(const bf16_t, merged), D_MODEL, NTOK, mt * 256, WSP(const bf16_t, WoT) + (long)nt * 256 * D_MODEL, D_MODEL, 256, D_MODEL, lds, [&](int) { return true; }, [&](const float* st, int m0, int nq) { epi_wout(p, st, m0, nt * 256 + nq); }, [&](int row, int col, const f32x4& v0, const f32x4& v1, int nq) { epid_store_bf16(WSP(bf16_t, y), D_MODEL, row, nt * 256 + nq + col, v0, v1); }); } }
  gsync(gb);
  for (int rep = 0; rep < REPS(8); ++rep) if (PH_ON(8)) { const Params p = PLOAD(p_arg); phase_postattn(p); }
  gsync(gb);
  for (int rep = 0; rep < REPS(9); ++rep) if (PH_ON(9)) { const Params p = PLOAD(p_arg); const int nM = (NTOK + 255) / 256, nN = 2048 / 256;
    for (int tile = bid; tile < nM * nN; tile += G) { const int mt = tile % nM, nt = tile / nM;
      gemm_tile8(WSP(const bf16_t, h2), D_MODEL, NTOK, mt * 256, WSP(const bf16_t, WpqT) + (long)nt * 256 * D_MODEL, D_MODEL, 256, D_MODEL, lds, [&](int) { return true; }, [&](const float* st, int m0, int nq) { epi_pq(p, st, m0, nt * 256 + nq); }, [&](int row, int col, const f32x4& v0, const f32x4& v1, int nq) { epid_store_bf16(WSP(bf16_t, qry), 2048, row, nt * 256 + nq + col, v0, v1); });
#ifndef HOST_EMU
      __builtin_amdgcn_fence(__ATOMIC_RELEASE, "workgroup"); __syncthreads(); __builtin_amdgcn_fence(__ATOMIC_ACQUIRE, "workgroup");
#else
      __syncthreads();
#endif
      for (int hp = 2 * nt; hp < 2 * nt + 2; ++hp)
        gemm_tile(WSP(const bf16_t, qry) + hp * 128, 2048, NTOK, mt * 256, WSP(const bf16_t, SK) + (long)hp * 128 * 128, 128, 128, 128, lds, [&](const float* st, int m0, int) { epi_sc(p, st, m0, hp * 128); }); } }
#ifdef HOST_EMU
  gsync(gb);
#endif
  gsync(gb);
  for (int rep = 0; rep < REPS(11); ++rep) if (PH_ON(11)) { const Params p = PLOAD(p_arg); phase_peer_topk(p); }
  gsync(gb);
  for (int rep = 0; rep < REPS(12); ++rep) if (PH_ON(12)) { const Params p = PLOAD(p_arg); phase_peer_u(p); }
  gsync(gb);
  for (int rep = 0; rep < REPS(13); ++rep) if (PH_ON(13)) { const Params p = PLOAD(p_arg); phase_peer_w(p); }
  gsync(gb);
  for (int rep = 0; rep < REPS(14); ++rep) if (PH_ON(14)) { const Params p = PLOAD(p_arg); phase_peer_v(p); }
  gsync(gb);
  if (PH_ON(15)) { const Params p = PLOAD(p_arg); phase_peer_final(p); }
}

#ifndef HOST_EMU
extern "C" void kernel_launch(void* const* d_in, const int* in_sizes, int n_in, void* d_out, int out_size, void* d_ws, size_t ws_size, hipStream_t stream) {
  static int grid_blocks = 0;
  if (!grid_blocks) {
    int dev = 0, cus = 0, per_cu = 0;
    (void)hipGetDevice(&dev);
    (void)hipDeviceGetAttribute(&cus, hipDeviceAttributeMultiprocessorCount, dev);
    (void)hipFuncSetAttribute((const void*)fwd_kernel, hipFuncAttributeMaxDynamicSharedMemorySize, LDS_BYTES);
    (void)hipOccupancyMaxActiveBlocksPerMultiprocessor(&per_cu, fwd_kernel, NTHREADS, LDS_BYTES);
    per_cu = 1;
    grid_blocks = cus * per_cu;
  }
  Params p{};
  p.x = (const float*)d_in[0]; p.c = (const float*)d_in[1]; p.pos = (const int*)d_in[2];
  { int i = 3;
    p.ada_w = (const float*)d_in[i++]; p.ada_b = (const float*)d_in[i++]; p.attn_pre_g = (const float*)d_in[i++]; p.attn_post_g = (const float*)d_in[i++];
    p.w_in = (const float*)d_in[i++]; p.cmp_pe = (const float*)d_in[i++]; p.cmp_w1 = (const float*)d_in[i++]; p.cmp_b1 = (const float*)d_in[i++]; p.cmp_w2 = (const float*)d_in[i++];
    p.mla_q_norm_g = (const float*)d_in[i++]; p.mla_w_q_up = (const float*)d_in[i++]; p.mla_kv_norm_g = (const float*)d_in[i++]; p.mla_w_kv_up = (const float*)d_in[i++];
    p.w_branch_nsa = (const float*)d_in[i++]; p.w_branch_mla = (const float*)d_in[i++]; p.w_out = (const float*)d_in[i++]; p.ffn_pre_g = (const float*)d_in[i++]; p.ffn_post_g = (const float*)d_in[i++];
    p.peer_w_q = (const float*)d_in[i++]; p.peer_sub_keys = (const float*)d_in[i++]; p.peer_u = (const float*)d_in[i++]; p.peer_v = (const float*)d_in[i++]; }
  p.out = (float*)d_out; p.ws = (char*)d_ws;
  if (ws_size < WL.total) { fprintf(stderr, "workspace too small: %zu < %zu\n", ws_size, (size_t)WL.total); return; }
  (void)hipMemsetAsync((char*)d_ws + WL.bar, 0, 16384, stream);
  void* args[] = {&p};
  hipError_t e = hipLaunchCooperativeKernel((void*)fwd_kernel, dim3(grid_blocks), dim3(NTHREADS), args, LDS_BYTES, stream);
  if (e != hipSuccess) fprintf(stderr, "cooperative launch failed: %s (grid %d)\n", hipGetErrorString(e), grid_blocks);
}
#endif
```
